# Optimizing an MI355X kernel written in HIP

```python
import math
import jax
import jax.numpy as jnp
from jax import lax
import numpy as np

D_MODEL = 1024
BATCH = 16
SEQ = 2048
DEPTH = 2

CHUNK = 64
Q_BLOCK = 128
RMS_EPS = 1e-6

LRU_WIDTH = D_MODEL // 2
LRU_BLOCKS = 8
LRU_BLOCK_DIM = LRU_WIDTH // LRU_BLOCKS
CONV_WIDTH = 4
LRU_C = 8.0
MLSTM_WIDTH = D_MODEL // 2
MLSTM_HEADS = 4
MLSTM_HEAD_DIM = MLSTM_WIDTH // MLSTM_HEADS
AB_IN_COLS = 2 * LRU_WIDTH + 4 * MLSTM_WIDTH + 2 * MLSTM_HEADS
AB_OUT_WIDTH = LRU_WIDTH + MLSTM_WIDTH

DIFF_HEADS = 8
DIFF_V_DIM = D_MODEL // DIFF_HEADS
DIFF_QK_DIM = DIFF_V_DIM // 2
DIFF_WIDTH = DIFF_HEADS * DIFF_V_DIM

N_GROUPS = 4
EXPERTS_PER_GROUP = 8
N_EXPERTS = N_GROUPS * EXPERTS_PER_GROUP
TOP_K = 2
EXPERT_FF = D_MODEL // 2

N_AB_LAYERS = (DEPTH + 1) // 2
N_DIFF_LAYERS = DEPTH // 2

kernel_name = 'chunk_causal_hybrid_rglru_mlstm_diffattn_hmoe'


def rms_norm(x, g):
    xf = x.astype(jnp.float32)
    y = xf * lax.rsqrt(jnp.mean(xf * xf, axis=-1, keepdims=True) + RMS_EPS)
    return (y * g.astype(jnp.float32)).astype(x.dtype)


def causal_depthwise_conv(x, w, b):
    out = lax.conv_general_dilated(
        x, w[:, None, :].astype(x.dtype), window_strides=(1,),
        padding=[(CONV_WIDTH - 1, 0)], dimension_numbers=('NWC', 'WIO', 'NWC'),
        feature_group_count=x.shape[-1])
    return out + b.astype(x.dtype)


def block_diag_linear(x, w, b):
    xb = x.reshape(x.shape[:-1] + (LRU_BLOCKS, LRU_BLOCK_DIM))
    y = jnp.einsum('bsnd,nde->bsne', xb, w.astype(jnp.float32))
    return y.reshape(x.shape) + b.astype(jnp.float32)


def rg_lru(x, w_r, b_r, w_i, b_i, lam):
    xf = x.astype(jnp.float32)
    r = jax.nn.sigmoid(block_diag_linear(xf, w_r, b_r))
    i = jax.nn.sigmoid(block_diag_linear(xf, w_i, b_i))
    log_a = LRU_C * r * jax.nn.log_sigmoid(lam.astype(jnp.float32))
    a = jnp.exp(log_a)
    u = jnp.sqrt(-jnp.expm1(2.0 * log_a)) * (i * xf)

    def combine(left, right):
        a1, b1 = left
        a2, b2 = right
        return a1 * a2, a2 * b1 + b2

    _, h = lax.associative_scan(combine, (a, u), axis=1)
    return h.astype(x.dtype)


def mlstm_chunkwise(q, k, v, i_pre, f_pre):
    B, S, H, dh = q.shape
    nc = S // CHUNK

    def to_chunks(t):
        t = t.astype(jnp.float32).reshape((B, nc, CHUNK, H) + t.shape[3:])
        return jnp.moveaxis(jnp.moveaxis(t, 1, 0), 3, 2)

    qc = to_chunks(q)
    kc = to_chunks(k) * (dh ** -0.5)
    vc = to_chunks(v)
    ic = to_chunks(i_pre)
    bc = jnp.cumsum(jax.nn.log_sigmoid(to_chunks(f_pre)), axis=-1)
    causal = jnp.tril(jnp.ones((CHUNK, CHUNK), dtype=bool))

    def step(carry, inp):
        C, n, m = carry
        q_, k_, v_, b_, i_ = inp
        g_ = b_[..., -1]
        log_d = jnp.where(causal, b_[..., :, None] - b_[..., None, :] + i_[..., None, :], -jnp.inf)
        log_inter = b_ + m[..., None]
        m_t = jnp.maximum(log_inter, jnp.max(log_d, axis=-1))
        w_intra = jnp.exp(log_d - m_t[..., None])
        w_inter = jnp.exp(log_inter - m_t)
        s = jnp.einsum('bhld,bhsd->bhls', q_, k_) * w_intra
        num = (w_inter[..., None] * jnp.einsum('bhld,bhde->bhle', q_, C)
               + jnp.einsum('bhls,bhse->bhle', s, v_))
        den = w_inter * jnp.einsum('bhld,bhd->bhl', q_, n) + jnp.sum(s, axis=-1)
        h = num / jnp.maximum(jnp.abs(den), jnp.exp(-m_t))[..., None]
        log_w = g_[..., None] - b_ + i_
        m_new = jnp.maximum(g_ + m, jnp.max(log_w, axis=-1))
        w_state = jnp.exp(log_w - m_new[..., None])
        decay = jnp.exp(g_ + m - m_new)
        C = decay[..., None, None] * C + jnp.einsum('bhs,bhsd,bhse->bhde', w_state, k_, v_)
        n = decay[..., None] * n + jnp.einsum('bhs,bhsd->bhd', w_state, k_)
        return (C, n, m_new), h

    init = (jnp.zeros((B, H, dh, dh), jnp.float32),
            jnp.zeros((B, H, dh), jnp.float32),
            jnp.zeros((B, H), jnp.float32))
    _, h = lax.scan(step, init, (qc, kc, vc, bc, ic))
    return jnp.moveaxis(h, 0, 1).transpose(0, 1, 3, 2, 4).reshape(B, S, H, dh)


def hybrid_lru_mlstm_mixer(xn, w_in, w_out, conv_w, conv_b, w_r, b_r, w_i, b_i, lam,
                           mb_i, mb_f, mnorm_g):
    B, S, _ = xn.shape
    proj = xn @ w_in
    idx = np.cumsum([LRU_WIDTH, LRU_WIDTH, MLSTM_WIDTH, MLSTM_WIDTH, MLSTM_WIDTH,
                     MLSTM_WIDTH, MLSTM_HEADS]).tolist()
    xa, ga, q, k, v, o, ip, fp = jnp.split(proj, idx, axis=-1)
    xa = causal_depthwise_conv(xa, conv_w, conv_b)
    ya = rg_lru(xa, w_r, b_r, w_i, b_i, lam) * jax.nn.gelu(ga)
    hs = (B, S, MLSTM_HEADS, MLSTM_HEAD_DIM)
    hb = mlstm_chunkwise(q.reshape(hs), k.reshape(hs), v.reshape(hs),
                         ip + mb_i.astype(ip.dtype), fp + mb_f.astype(fp.dtype))
    hb = rms_norm(hb, mnorm_g) * jax.nn.sigmoid(o.astype(jnp.float32)).reshape(hs)
    yb = hb.reshape(B, S, MLSTM_WIDTH).astype(xn.dtype)
    return jnp.concatenate([ya, yb], axis=-1) @ w_out


def diff_attention(xn, w_qkv, w_o, lq1, lk1, lq2, lk2, norm_g, lambda_init):
    B, S, _ = xn.shape
    H = DIFF_HEADS
    q, k, v = jnp.split(xn @ w_qkv, [DIFF_WIDTH, 2 * DIFF_WIDTH], axis=-1)
    q = q.reshape(B, S, H, 2, DIFF_QK_DIM)
    k = k.reshape(B, S, H, 2, DIFF_QK_DIM)
    v = v.reshape(B, S, H, DIFF_V_DIM)
    f32 = jnp.float32
    lam = (jnp.exp(jnp.sum(lq1.astype(f32) * lk1.astype(f32)))
           - jnp.exp(jnp.sum(lq2.astype(f32) * lk2.astype(f32))) + lambda_init)
    slopes = jnp.exp2(-8.0 * jnp.arange(1, H + 1, dtype=f32) / H)
    scale = DIFF_QK_DIM ** -0.5
    n_blocks = S // Q_BLOCK
    q_blocks = jnp.moveaxis(q.reshape(B, n_blocks, Q_BLOCK, H, 2, DIFF_QK_DIM), 1, 0)
    k_pos = jnp.arange(S)

    def attend_block(args):
        q_blk, blk = args
        q_pos = blk * Q_BLOCK + jnp.arange(Q_BLOCK)
        scores = jnp.einsum('bqhcd,bkhcd->bhcqk', q_blk, k).astype(f32) * scale
        dist = jnp.abs(q_pos[:, None] - k_pos[None, :]).astype(f32)
        scores = scores - (slopes[:, None, None] * dist)[None, :, None]
        allowed = (k_pos[None, :] // CHUNK) <= (q_pos[:, None] // CHUNK)
        probs = jax.nn.softmax(jnp.where(allowed, scores, -jnp.inf), axis=-1)
        diff = probs[:, :, 0] - lam * probs[:, :, 1]
        return jnp.einsum('bhqk,bkhe->bqhe', diff.astype(v.dtype), v)

    out = lax.map(attend_block, (q_blocks, jnp.arange(n_blocks)))
    out = jnp.moveaxis(out, 0, 1).reshape(B, S, H, DIFF_V_DIM)
    out = rms_norm(out, norm_g) * (1.0 - lambda_init)
    return out.reshape(B, S, DIFF_WIDTH) @ w_o


def hierarchical_moe(xn, w_group, b_group, w_expert, b_expert, w_up, w_down):
    B, S, D = xn.shape
    t = xn.reshape(B * S, D)
    f32 = jnp.float32
    group_logits = (t @ w_group).astype(f32) + b_group.astype(f32)
    group_prob = jax.nn.softmax(group_logits, axis=-1)
    g_idx = jnp.argmax(group_logits, axis=-1)
    g_weight = jnp.take_along_axis(group_prob, g_idx[:, None], axis=-1)
    e_logits = ((t @ w_expert).astype(f32) + b_expert.astype(f32)).reshape(-1, N_GROUPS, EXPERTS_PER_GROUP)
    in_group = jnp.take_along_axis(e_logits, g_idx[:, None, None], axis=1)[:, 0]
    top_logits, top_idx = lax.top_k(in_group, TOP_K)
    top_w = jax.nn.softmax(top_logits, axis=-1) * g_weight
    expert_id = g_idx[:, None] * EXPERTS_PER_GROUP + top_idx
    gates = jnp.sum(jax.nn.one_hot(expert_id, N_EXPERTS, dtype=f32) * top_w[..., None], axis=1)
    y = jnp.zeros((B * S, D), f32)
    for e in range(N_EXPERTS):
        h = t @ w_up[e]
        h = jax.nn.silu(h[:, :EXPERT_FF]) * h[:, EXPERT_FF:]
        y = y + gates[:, e:e + 1] * (h @ w_down[e]).astype(f32)
    return y.astype(xn.dtype).reshape(B, S, D)


def setup_inputs(seed: int = 0) -> dict:
    key = jax.random.key(seed)
    ks = jax.random.split(key, 32)
    f32 = jnp.float32

    def nrm(k, shape, scale):
        return jax.random.normal(k, shape, f32) * scale

    u = jax.random.uniform(ks[10], (N_AB_LAYERS, LRU_WIDTH), f32, minval=0.9, maxval=0.999)
    a0 = u ** (1.0 / LRU_C)
    lru_lambda = jnp.log(a0) - jnp.log1p(-a0)
    return {
        'x': nrm(ks[0], (BATCH, SEQ, D_MODEL), 1.0),
        'norm_mix_g': 1.0 + nrm(ks[1], (DEPTH, D_MODEL), 0.05),
        'norm_ffn_g': 1.0 + nrm(ks[2], (DEPTH, D_MODEL), 0.05),
        'ab_w_in': nrm(ks[3], (N_AB_LAYERS, D_MODEL, AB_IN_COLS), D_MODEL ** -0.5),
        'ab_w_out': nrm(ks[4], (N_AB_LAYERS, AB_OUT_WIDTH, D_MODEL), AB_OUT_WIDTH ** -0.5),
        'lru_conv_w': nrm(ks[5], (N_AB_LAYERS, CONV_WIDTH, LRU_WIDTH), CONV_WIDTH ** -0.5),
        'lru_conv_b': nrm(ks[6], (N_AB_LAYERS, LRU_WIDTH), 0.02),
        'lru_w_r': nrm(ks[7], (N_AB_LAYERS, LRU_BLOCKS, LRU_BLOCK_DIM, LRU_BLOCK_DIM), LRU_BLOCK_DIM ** -0.5),
        'lru_b_r': nrm(ks[8], (N_AB_LAYERS, LRU_WIDTH), 0.02),
        'lru_w_i': nrm(ks[9], (N_AB_LAYERS, LRU_BLOCKS, LRU_BLOCK_DIM, LRU_BLOCK_DIM), LRU_BLOCK_DIM ** -0.5),
        'lru_b_i': nrm(ks[11], (N_AB_LAYERS, LRU_WIDTH), 0.02),
        'lru_lambda': lru_lambda,
        'mlstm_b_i': nrm(ks[12], (N_AB_LAYERS, MLSTM_HEADS), 0.1),
        'mlstm_b_f': jnp.linspace(3.0, 6.0, MLSTM_HEADS, dtype=f32)[None, :] + nrm(ks[13], (N_AB_LAYERS, MLSTM_HEADS), 0.1),
        'mlstm_norm_g': 1.0 + nrm(ks[14], (N_AB_LAYERS, MLSTM_HEADS, MLSTM_HEAD_DIM), 0.05),
        'diff_w_qkv': nrm(ks[15], (N_DIFF_LAYERS, D_MODEL, 3 * DIFF_WIDTH), D_MODEL ** -0.5),
        'diff_w_o': nrm(ks[16], (N_DIFF_LAYERS, DIFF_WIDTH, D_MODEL), DIFF_WIDTH ** -0.5),
        'diff_lambda_q1': nrm(ks[17], (N_DIFF_LAYERS, DIFF_QK_DIM), 0.1),
        'diff_lambda_k1': nrm(ks[18], (N_DIFF_LAYERS, DIFF_QK_DIM), 0.1),
        'diff_lambda_q2': nrm(ks[19], (N_DIFF_LAYERS, DIFF_QK_DIM), 0.1),
        'diff_lambda_k2': nrm(ks[20], (N_DIFF_LAYERS, DIFF_QK_DIM), 0.1),
        'diff_norm_g': 1.0 + nrm(ks[21], (N_DIFF_LAYERS, DIFF_HEADS, DIFF_V_DIM), 0.05),
        'moe_w_group': nrm(ks[22], (DEPTH, D_MODEL, N_GROUPS), D_MODEL ** -0.5),
        'moe_b_group': nrm(ks[23], (DEPTH, N_GROUPS), 0.01),
        'moe_w_expert': nrm(ks[24], (DEPTH, D_MODEL, N_EXPERTS), D_MODEL ** -0.5),
        'moe_b_expert': nrm(ks[25], (DEPTH, N_EXPERTS), 0.01),
        'moe_w_up': nrm(ks[26], (DEPTH, N_EXPERTS, D_MODEL, 2 * EXPERT_FF), D_MODEL ** -0.5),
        'moe_w_down': nrm(ks[27], (DEPTH, N_EXPERTS, EXPERT_FF, D_MODEL), EXPERT_FF ** -0.5),
        'final_norm_g': 1.0 + nrm(ks[28], (D_MODEL,), 0.05),
    }


def reference(x, norm_mix_g, norm_ffn_g, ab_w_in, ab_w_out, lru_conv_w, lru_conv_b, lru_w_r,
              lru_b_r, lru_w_i, lru_b_i, lru_lambda, mlstm_b_i, mlstm_b_f, mlstm_norm_g,
              diff_w_qkv, diff_w_o, diff_lambda_q1, diff_lambda_k1, diff_lambda_q2,
              diff_lambda_k2, diff_norm_g, moe_w_group, moe_b_group, moe_w_expert,
              moe_b_expert, moe_w_up, moe_w_down, final_norm_g):
    h = x
    for layer in range(DEPTH):
        hn = rms_norm(h, norm_mix_g[layer])
        j = layer // 2
        if layer % 2 == 0:
            h = h + hybrid_lru_mlstm_mixer(
                hn, ab_w_in[j], ab_w_out[j], lru_conv_w[j], lru_conv_b[j], lru_w_r[j],
                lru_b_r[j], lru_w_i[j], lru_b_i[j], lru_lambda[j], mlstm_b_i[j],
                mlstm_b_f[j], mlstm_norm_g[j])
        else:
            lambda_init = 0.8 - 0.6 * math.exp(-0.3 * layer)
            h = h + diff_attention(
                hn, diff_w_qkv[j], diff_w_o[j], diff_lambda_q1[j], diff_lambda_k1[j],
                diff_lambda_q2[j], diff_lambda_k2[j], diff_norm_g[j], lambda_init)
        h = h + hierarchical_moe(rms_norm(h, norm_ffn_g[layer]), moe_w_group[layer],
                                 moe_b_group[layer], moe_w_expert[layer], moe_b_expert[layer],
                                 moe_w_up[layer], moe_w_down[layer])
    return rms_norm(h, final_norm_g)
```

```cpp
#include <hip/hip_runtime.h>
#include <math.h>
#include <stdint.h>

#define T_   32768
#define D_   1024
#define S_   2048
#define NB_  16
#define PROJ_N 3080
#define EPS_ 1e-6f

typedef unsigned short bf16_t;
typedef short bf16x8 __attribute__((ext_vector_type(8)));
typedef short s16x4 __attribute__((ext_vector_type(4)));
typedef float f32x4 __attribute__((ext_vector_type(4)));
typedef float f32x2 __attribute__((ext_vector_type(2)));
typedef float f32x16 __attribute__((ext_vector_type(16)));
typedef unsigned u32x4 __attribute__((ext_vector_type(4)));
typedef unsigned u32x2 __attribute__((ext_vector_type(2)));
#define LAS __attribute__((address_space(3)))
#define DI __device__ __forceinline__
DI int opaque_tid() { int t = (int)threadIdx.x; asm volatile("" : "+v"(t)); return t; }
DI int lane_id() { int l = (int)__builtin_amdgcn_mbcnt_hi(~0u, __builtin_amdgcn_mbcnt_lo(~0u, 0u)); asm volatile("" : "+v"(l)); return l; }

typedef __bf16 nbf16x2 __attribute__((ext_vector_type(2)));
DI unsigned cvt_pk_bf16(float lo, float hi) { const f32x2 v = {lo, hi}; return __builtin_bit_cast(unsigned, __builtin_convertvector(v, nbf16x2)); }
DI float wave_sum_uniform(float v) {
    int t = __builtin_bit_cast(int, v);
    v += __builtin_bit_cast(float, __builtin_amdgcn_update_dpp(0, t, 0xB1, 0xF, 0xF, true)); t = __builtin_bit_cast(int, v);
    v += __builtin_bit_cast(float, __builtin_amdgcn_update_dpp(0, t, 0x4E, 0xF, 0xF, true)); t = __builtin_bit_cast(int, v);
    v += __builtin_bit_cast(float, __builtin_amdgcn_update_dpp(0, t, 0x124, 0xF, 0xF, true)); t = __builtin_bit_cast(int, v);
    v += __builtin_bit_cast(float, __builtin_amdgcn_update_dpp(0, t, 0x128, 0xF, 0xF, true)); t = __builtin_bit_cast(int, v);
    return (__builtin_bit_cast(float, __builtin_amdgcn_readlane(t, 0)) + __builtin_bit_cast(float, __builtin_amdgcn_readlane(t, 16)))
         + (__builtin_bit_cast(float, __builtin_amdgcn_readlane(t, 32)) + __builtin_bit_cast(float, __builtin_amdgcn_readlane(t, 48)));
}
DI float bf_lo(unsigned w) { return __uint_as_float(w << 16); }
DI float bf_hi(unsigned w) { return __uint_as_float(w & 0xffff0000u); }
DI float bf2f(bf16_t b) { return __uint_as_float(((unsigned)b) << 16); }

#define XB_TMO      128
#define XB_XCNT(j)  (256  + 64 * (j))
#define XB_XSUB(j)  (1280 + 64 * (j))
#define XB_XGEN(j)  (2304 + 64 * (j))
#define XB_TOP      3328
#define XB_TOPGEN   3392
#define XCD_BAR_WORDS 3456
#define XB_SPIN_CAP (1u << 18)
DI unsigned xb_ld(unsigned* p)              { return __hip_atomic_load(p, __ATOMIC_RELAXED, __HIP_MEMORY_SCOPE_AGENT); }
DI unsigned xb_add(unsigned* p, unsigned v) { return __hip_atomic_fetch_add(p, v, __ATOMIC_RELAXED, __HIP_MEMORY_SCOPE_AGENT); }
DI unsigned xb_xcc_id() { return (unsigned)__builtin_amdgcn_s_getreg((3 << 11) | 20) & 0xFu; }
#define XB_SPIN(cond, bar) do { unsigned _sp = 0; while (cond) { __builtin_amdgcn_s_sleep(1); \
    if ((++_sp & 255u) == 0u) { if (xb_ld(&(bar)[XB_TMO])) break; if (_sp > XB_SPIN_CAP) { atomicAdd(&(bar)[XB_TMO], 1u); break; } } } } while (0)
struct XcdBarrier { unsigned* bar; unsigned x; volatile LAS unsigned* st; };
DI XcdBarrier xcd_barrier_post(unsigned* bar, volatile LAS unsigned* st) {
    XcdBarrier b; b.bar = bar; b.x = xb_xcc_id(); b.st = st;
    if (threadIdx.x == 0) (void)xb_add(&bar[XB_XCNT(b.x)], 1u);
    return b;
}
DI void xcd_barrier_complete(unsigned* bar, unsigned x, unsigned& nloc, unsigned& nx) {
    const unsigned G = gridDim.x * gridDim.y * gridDim.z;
    unsigned sum, cnt, mine, sp = 0u;
    for (;;) {
        sum = 0u; cnt = 0u; mine = 0u;
#pragma unroll
        for (unsigned j = 0; j < 16; ++j) { const unsigned c = xb_ld(&bar[XB_XCNT(j)]); sum += c; cnt += (c > 0u) ? 1u : 0u; mine = (j == x) ? c : mine; }
        if (sum == G) break;
        __builtin_amdgcn_s_sleep(1);
        if ((++sp & 255u) == 0u) { if (xb_ld(&bar[XB_TMO])) break; if (sp > XB_SPIN_CAP) { atomicAdd(&bar[XB_TMO], 1u); break; } }
    }
    nloc = mine > 0u ? mine : 1u; nx = cnt > 0u ? cnt : 1u;
}
DI void xcd_barrier(const XcdBarrier& b) {
    asm volatile("s_waitcnt vmcnt(0)" ::: "memory");
    __syncthreads();
    if (threadIdx.x == 0) {
        unsigned* bar = b.bar;
        __builtin_amdgcn_s_waitcnt(0);
        unsigned nloc = b.st[0], nx = b.st[1];
        if (nloc == 0u) { xcd_barrier_complete(bar, b.x, nloc, nx); b.st[0] = nloc; b.st[1] = nx; }
        const unsigned old = xb_add(&bar[XB_XSUB(b.x)], 1u);
        const unsigned gen = old / nloc;
        if (old + 1u == (gen + 1u) * nloc) {
            __builtin_amdgcn_fence(__ATOMIC_RELEASE, "agent");
            asm volatile("s_waitcnt vmcnt(0)" ::: "memory");
            const unsigned og = xb_add(&bar[XB_TOP], 1u);
            const unsigned tg = og / nx;
            if (og + 1u == (tg + 1u) * nx) xb_add(&bar[XB_TOPGEN], 1u);
            else XB_SPIN(xb_ld(&bar[XB_TOPGEN]) == tg, bar);
            __builtin_amdgcn_fence(__ATOMIC_ACQUIRE, "agent");
            xb_add(&bar[XB_XGEN(b.x)], 1u);
            asm volatile("s_waitcnt vmcnt(0)" ::: "memory");
        } else {
            XB_SPIN(xb_ld(&bar[XB_XGEN(b.x)]) == gen, bar);
            __builtin_amdgcn_fence(__ATOMIC_ACQUIRE, "agent");
            asm volatile("s_waitcnt vmcnt(0)" ::: "memory");
        }
    }
    __syncthreads();
}

#ifndef GM_SKEW
#define GM_SKEW 0
#endif
namespace gm {
constexpr int BM = 256, BK = 64, HALF = 128, HTB = HALF * BK * 2, STAGE_BYTES = 8 * HTB, NXCD = 8, WGM = 8;
DI int lds_byte(int r, int c) { const int st = (r >> 4) * 2 + (c >> 5), rr = r & 15, cc = c & 31, ob = rr * 64 + cc * 2; return st * 1024 + (ob ^ (((ob >> 9) & 1) << 5)); }
DI void stage_rc(int b, int& R, int& C) { const int st = b / 1024, sb = b % 1024, swz = sb ^ (((sb >> 9) & 1) << 5); R = (st >> 1) * 16 + swz / 64; C = (st & 1) * 32 + (swz % 64) / 2; }
DI int rho16(int i) { return (i >> 1) + 8 * (i & 1); }
DI int perm32(int rho) { const int n = rho >> 4, i = rho & 15; return 8 * (i >> 2) + 4 * n + (i & 3); }

struct Unit {
    const char* aB;
    const char* bB;
    int pm, pn, e, cnt;
    int mt;
};
#define GM_NO_SCHED_SIDE DI void side_issue(LAS unsigned char*, const gm::Unit&, int) const {} DI void fill_va(LAS unsigned char*, const gm::Unit&, unsigned (&)[2][2], int, int) const {}
#define GM_NO_EPI_SIDE DI void side_issue(LAS unsigned char*, const gm::Unit&, int) const {}
DI bool static_tile(int i, int G, int c, int nM, int nN, int& pm, int& pn) {
    const int nwg = nM * nN; const long L = (long)i * G + c; if (L >= nwg) return false;
    int wgid = (int)L; { const int q = nwg / NXCD, r = nwg % NXCD, xcd = wgid % NXCD, off = wgid / NXCD; wgid = (xcd < r ? xcd * (q + 1) : r * (q + 1) + (xcd - r) * q) + off; }
    const int nig = WGM * nN, gid = wgid / nig, fm = gid * WGM, gsz = (nM - fm) < WGM ? (nM - fm) : WGM;
    pm = fm + ((wgid % nig) % gsz); pn = (wgid % nig) / gsz; return true;
}
struct PlainSched {
    static constexpr bool GATHER = false;
    const bf16_t* A; const bf16_t* Bt; int nM, nN, K, G, c; int tid16;
    DI bool next(int i, Unit& u) const {
        int pm, pn; if (!static_tile(i, G, c, nM, nN, pm, pn)) return false;
        u.aB = (const char*)A + (size_t)pm * 256 * K * 2; u.bB = (const char*)Bt + (size_t)pn * 256 * K * 2; u.pm = pm; u.pn = pn; u.e = 0; u.cnt = 256; u.mt = 0;
        return true;
    }
    DI void va_direct(const Unit&, unsigned (&va)[2][2]) const { int R, C; stage_rc(opaque_tid() * 16, R, C); R = (R & ~15) + rho16(R & 15); const unsigned v = (unsigned)(R * K + C) * 2u; va[0][0] = v; va[0][1] = v; va[1][0] = v; va[1][1] = v; }
    GM_NO_SCHED_SIDE
};

template <class Epi, class Sched>
DI void gemm_phase(LAS unsigned char* lds, const int K, const Sched& S, const Epi& E) {
    const int tid = opaque_tid(), wid = __builtin_amdgcn_readfirstlane(tid >> 6), lane = tid & 63, wr = wid >> 2, wc = wid & 3, fr = lane & 15, fq = lane >> 4;
    const int nt = K / BK;
    unsigned voffB[2];
#pragma unroll
    for (int i = 0; i < 2; ++i) { int R, C; stage_rc(tid * 16 + i * 8192, R, C); const int Rb = 64 * (R >> 5) + perm32(R & 31); voffB[i] = (unsigned)(Rb * K + C) * 2u; }
    const size_t kstep = (size_t)(BK * 2);
    const size_t hstepB = (size_t)32 * K * 2;
    const unsigned ldsw = (unsigned)wid * 1024u;
    const int aoff = lds_byte(wr * 64 + fr, fq * 8), boff = lds_byte(wc * 32 + fr, fq * 8);
#define GM_SA(b, h) (((b) * 2 + (h)) * HTB)
#define GM_SB(b, h) ((4 + (b) * 2 + (h)) * HTB)
#define GM_STAGE_B(bufoff, gbase) do { _Pragma("unroll") for (int _i = 0; _i < 2; ++_i) \
        __builtin_amdgcn_global_load_lds((const unsigned*)((const char*)(gbase) + voffB[_i]), (LAS unsigned*)(lds + (bufoff) + ldsw + _i * 8192), 16, 0, 0); } while (0)
#define GM_STAGE_A(bufoff, gbase, h, v0, v1) do { \
        const char* _g0 = (const char*)(gbase) + (Sched::GATHER ? (size_t)0 : (size_t)((h) * 128) * K * 2); const char* _g1 = (const char*)(gbase) + (Sched::GATHER ? (size_t)0 : (size_t)((h) * 128 + 64) * K * 2); \
        __builtin_amdgcn_global_load_lds((const unsigned*)(_g0 + (v0)), (LAS unsigned*)(lds + (bufoff) + ldsw), 16, 0, 0); \
        __builtin_amdgcn_global_load_lds((const unsigned*)(_g1 + (v1)), (LAS unsigned*)(lds + (bufoff) + ldsw + 8192), 16, 0, 0); } while (0)
#define GM_VA(h, p) (Sched::GATHER ? va[h][p] : va[0][0])
#define GM_LDA(dst, b, h) do { _Pragma("unroll") for (int m = 0; m < 4; ++m) _Pragma("unroll") for (int k = 0; k < 2; ++k) dst[m][k] = *(const LAS bf16x8*)(lds + GM_SA(b, h) + aoff + m * 2048 + k * 1024); } while (0)
#define GM_LDB(dst, b, h) do { _Pragma("unroll") for (int n = 0; n < 2; ++n) _Pragma("unroll") for (int k = 0; k < 2; ++k) dst[n][k] = *(const LAS bf16x8*)(lds + GM_SB(b, h) + boff + n * 2048 + k * 1024); } while (0)
#define GM_MMA(ai, bj, At, Bt) do { __builtin_amdgcn_s_setprio(1); _Pragma("unroll") for (int m = 0; m < 4; ++m) _Pragma("unroll") for (int n = 0; n < 2; ++n) _Pragma("unroll") for (int k = 0; k < 2; ++k) \
        acc[ai][bj][m][n] = __builtin_amdgcn_mfma_f32_16x16x32_bf16(Bt[n][k], At[m][k], acc[ai][bj][m][n], 0, 0, 0); __builtin_amdgcn_s_setprio(0); } while (0)
#define GM_WAIT_V(n) asm volatile("s_waitcnt vmcnt(" #n ")" ::: "memory")
#define GM_WAIT_L(n) asm volatile("s_waitcnt lgkmcnt(" #n ")" ::: "memory")
#define GM_BAR __builtin_amdgcn_s_barrier()
#define GM_SCHED __builtin_amdgcn_sched_barrier(0)
    Unit cur, nxt; int ui = 0;
    if (!S.next(0, cur)) return;
    unsigned va[2][2]; S.va_direct(cur, va);
    int tfirst = 0; asm volatile("" : "+s"(tfirst));
    LAS unsigned char* side = lds + STAGE_BYTES + 8192;
    { const int grp = ((int)blockIdx.x >> 3) & 3; for (int i = 0; i < grp * GM_SKEW; ++i) __builtin_amdgcn_s_sleep(32); }
    f32x4 acc[2][2][4][2];
#pragma unroll
    for (int a = 0; a < 2; ++a)
#pragma unroll
        for (int b = 0; b < 2; ++b)
#pragma unroll
            for (int m = 0; m < 4; ++m)
#pragma unroll
                for (int n = 0; n < 2; ++n) acc[a][b][m][n] = (f32x4){0.f, 0.f, 0.f, 0.f};
    bf16x8 At[4][2], B0[2][2], B1[2][2];
    GM_STAGE_B(GM_SB(0, 0), cur.bB); GM_STAGE_A(GM_SA(0, 0), cur.aB, 0, GM_VA(0, 0), GM_VA(0, 1)); GM_STAGE_B(GM_SB(0, 1), cur.bB + hstepB); GM_STAGE_A(GM_SA(0, 1), cur.aB, 1, GM_VA(1, 0), GM_VA(1, 1));
    if (wr == 1) GM_BAR;
    GM_WAIT_V(4); GM_BAR;
    GM_STAGE_B(GM_SB(1, 0), cur.bB + kstep); GM_STAGE_A(GM_SA(1, 0), cur.aB + kstep, 0, GM_VA(0, 0), GM_VA(0, 1)); GM_STAGE_B(GM_SB(1, 1), cur.bB + hstepB + kstep);
    GM_WAIT_V(6); GM_BAR;
    for (;;) {
        const bool has_next = S.next(ui + 1, nxt);
        if (!has_next) nxt = cur;
        for (int t = 0; t < nt; t += 2) {
            const bool last = (t == nt - 2);
            const char* a1 = cur.aB + (size_t)(t + 1) * kstep;
            const char* a2 = last ? nxt.aB : cur.aB + (size_t)(t + 2) * kstep; const char* b2 = last ? nxt.bB : cur.bB + (size_t)(t + 2) * kstep;
            const char* a3 = a2 + kstep; const char* b3 = b2 + kstep;
            if (Sched::GATHER && last && has_next) S.fill_va(side, nxt, va, 0, wid * 64 + lane_id());
            GM_LDB(B0, 0, 0); GM_SCHED; GM_LDA(At, 0, 0); GM_STAGE_A(GM_SA(1, 1), a1, 1, GM_VA(1, 0), GM_VA(1, 1));
            GM_WAIT_L(8); GM_BAR; GM_WAIT_L(0); GM_MMA(0, 0, At, B0); GM_BAR; GM_SCHED;
            GM_LDB(B1, 0, 1); GM_STAGE_B(GM_SB(0, 0), b2);
            GM_BAR; GM_WAIT_L(0); GM_MMA(0, 1, At, B1); GM_BAR;
            GM_LDA(At, 0, 1); GM_STAGE_A(GM_SA(0, 0), a2, 0, GM_VA(0, 0), GM_VA(0, 1));
            GM_BAR; GM_WAIT_L(0); GM_MMA(1, 0, At, B0); GM_BAR; GM_SCHED;
            GM_STAGE_B(GM_SB(0, 1), b2 + hstepB);
            GM_WAIT_V(6); GM_BAR; GM_MMA(1, 1, At, B1); GM_BAR;
            if (t == tfirst && wid == 0) { const int l2 = lane_id(); E.side_issue(side, cur, l2); if (has_next) S.side_issue(side, nxt, l2); }
            if (Sched::GATHER && last && has_next) S.fill_va(side, nxt, va, 1, wid * 64 + lane_id());
            GM_LDB(B0, 1, 0); GM_SCHED; GM_LDA(At, 1, 0); GM_STAGE_A(GM_SA(0, 1), a2, 1, GM_VA(1, 0), GM_VA(1, 1));
            GM_WAIT_L(8); GM_BAR; GM_WAIT_L(0); GM_MMA(0, 0, At, B0); GM_BAR; GM_SCHED;
            GM_LDB(B1, 1, 1); GM_STAGE_B(GM_SB(1, 0), b3);
            GM_BAR; GM_WAIT_L(0); GM_MMA(0, 1, At, B1); GM_BAR;
            GM_LDA(At, 1, 1); GM_STAGE_A(GM_SA(1, 0), a3, 0, GM_VA(0, 0), GM_VA(0, 1));
            GM_BAR; GM_WAIT_L(0); GM_MMA(1, 0, At, B0); GM_BAR; GM_SCHED;
            GM_STAGE_B(GM_SB(1, 1), b3 + hstepB);
            GM_WAIT_V(6); GM_BAR; GM_MMA(1, 1, At, B1); GM_BAR;
        }
        { const int l2 = lane_id(); E(acc, cur, wr, wc, l2 & 15, l2 >> 4, side); }
        if (!has_next) break;
#pragma unroll
        for (int a = 0; a < 2; ++a)
#pragma unroll
            for (int b = 0; b < 2; ++b)
#pragma unroll
                for (int m = 0; m < 4; ++m)
#pragma unroll
                    for (int n = 0; n < 2; ++n) acc[a][b][m][n] = (f32x4){0.f, 0.f, 0.f, 0.f};
        cur = nxt; ++ui;
    }
    GM_WAIT_V(0);
    if (wr == 0) GM_BAR;
    GM_BAR;
#undef GM_SA
#undef GM_SB
#undef GM_STAGE_A
#undef GM_VA
#undef GM_STAGE_B
#undef GM_LDA
#undef GM_LDB
#undef GM_MMA
#undef GM_WAIT_V
#undef GM_WAIT_L
#undef GM_BAR
#undef GM_SCHED
}

DI unsigned dpp_ror8(unsigned x) { return (unsigned)__builtin_amdgcn_update_dpp(0, (int)x, 0xB1, 0xF, 0xF, true); }
DI void xchg_lines(const u32x4& p0, const u32x4& p1, int fr, u32x4& a, u32x4& b) {
    const bool lo = (fr & 1) == 0;
    const u32x4 send = lo ? p1 : p0; u32x4 recv;
    recv.x = dpp_ror8(send.x); recv.y = dpp_ror8(send.y); recv.z = dpp_ror8(send.z); recv.w = dpp_ror8(send.w);
    a = lo ? p0 : recv; b = lo ? recv : p1;
}
DI u32x4 pack_piece(const f32x4& v0, const f32x4& v1) { u32x4 w; w.x = cvt_pk_bf16(v0[0], v0[1]); w.y = cvt_pk_bf16(v0[2], v0[3]); w.z = cvt_pk_bf16(v1[0], v1[1]); w.w = cvt_pk_bf16(v1[2], v1[3]); return w; }
struct EpiPlainBf16 {
    static constexpr bool PERM = true; GM_NO_EPI_SIDE
    bf16_t* O; int ldc;
    DI void operator()(const f32x4 (&acc)[2][2][4][2], const Unit& u, int wr, int wc, int fr, int fq, LAS unsigned char* side) const {
        bf16_t* base = O + (size_t)(u.pm * BM + wr * 64 + (fr >> 1)) * ldc + u.pn * BM + wc * 64 + 32 * (fr & 1) + 8 * fq;
#pragma unroll
        for (int ai = 0; ai < 2; ++ai)
#pragma unroll
            for (int m = 0; m < 4; ++m) { u32x4 a, b; xchg_lines(pack_piece(acc[ai][0][m][0], acc[ai][0][m][1]), pack_piece(acc[ai][1][m][0], acc[ai][1][m][1]), fr, a, b);
                bf16_t* rp = base + (size_t)(ai * HALF + m * 16) * ldc;
                __builtin_nontemporal_store(a, (u32x4*)rp); __builtin_nontemporal_store(b, (u32x4*)(rp + (size_t)8 * ldc)); }
    }
};
struct EpiQK {
    static constexpr bool PERM = true; GM_NO_EPI_SIDE
    bf16_t* O; unsigned* kmax;
    DI void operator()(const f32x4 (&acc)[2][2][4][2], const Unit& u, int wr, int wc, int fr, int fq, LAS unsigned char* side) const {
        bf16_t* base = O + (size_t)(u.pm * BM + wr * 64 + (fr >> 1)) * 3072 + u.pn * BM + wc * 64 + 32 * (fr & 1) + 8 * fq;
        float pm[2] = {0.f, 0.f};
        const bool iskey = (u.pn >= 4 && u.pn < 8);
#pragma unroll
        for (int ai = 0; ai < 2; ++ai)
#pragma unroll
            for (int m = 0; m < 4; ++m) { u32x4 a, b; xchg_lines(pack_piece(acc[ai][0][m][0], acc[ai][0][m][1]), pack_piece(acc[ai][1][m][0], acc[ai][1][m][1]), fr, a, b);
                bf16_t* rp = base + (size_t)(ai * HALF + m * 16) * 3072;
                __builtin_nontemporal_store(a, (u32x4*)rp); __builtin_nontemporal_store(b, (u32x4*)(rp + (size_t)8 * 3072));
                if (iskey) {
#pragma unroll
                for (int bj = 0; bj < 2; ++bj) { const f32x4 v0 = acc[ai][bj][m][0], v1 = acc[ai][bj][m][1];
                    float s = v0[0] * v0[0] + v0[1] * v0[1] + v0[2] * v0[2] + v0[3] * v0[3] + v1[0] * v1[0] + v1[1] * v1[1] + v1[2] * v1[2] + v1[3] * v1[3];
                    s += __shfl_xor(s, 16); s += __shfl_xor(s, 32);
                    pm[bj] = fmaxf(pm[bj], s); } } }
        if (iskey) {
#pragma unroll
            for (int bj = 0; bj < 2; ++bj) { float v = pm[bj];
                v = fmaxf(v, __shfl_xor(v, 1)); v = fmaxf(v, __shfl_xor(v, 2)); v = fmaxf(v, __shfl_xor(v, 4)); v = fmaxf(v, __shfl_xor(v, 8));
                const int col = (u.pn - 4) * 256 + wc * 64 + bj * 32;
                if (fr == 0 && fq == 0) atomicMax(kmax + (((u.pm >> 3) * 8 + (col >> 7)) * 4 + ((col >> 5) & 3)), __float_as_uint(v)); }
        }
    }
};
template <int FULL> struct EpiProbeLines {
    static constexpr bool PERM = true; GM_NO_EPI_SIDE
    bf16_t* O; int ldc;
    DI void operator()(const f32x4 (&acc)[2][2][4][2], const Unit& u, int wr, int wc, int fr, int fq, LAS unsigned char* side) const {
        const int lane = fq * 16 + fr;
#pragma unroll
        for (int ai = 0; ai < 2; ++ai)
#pragma unroll
            for (int m = 0; m < 4; ++m) {
#pragma unroll
                for (int bj = 0; bj < 2; ++bj) { const u32x4 w = pack_piece(acc[ai][bj][m][0], acc[ai][bj][m][1]);
                    bf16_t* dst = O + (size_t)(u.pm * BM + wr * 64 + ai * HALF + m * 16 + 8 * bj + (lane >> 3)) * ldc + u.pn * BM + wc * 64 + 8 * (lane & 7);
                    *(u32x4*)dst = w; } }
    }
};
struct EpiNone {
    static constexpr bool PERM = true; GM_NO_EPI_SIDE
    DI void operator()(const f32x4 (&acc)[2][2][4][2], const Unit& u, int wr, int wc, int fr, int fq, LAS unsigned char* side) const {
#pragma unroll
        for (int ai = 0; ai < 2; ++ai)
#pragma unroll
            for (int m = 0; m < 4; ++m)
#pragma unroll
                for (int bj = 0; bj < 2; ++bj) { asm volatile("" :: "v"(acc[ai][bj][m][0]), "v"(acc[ai][bj][m][1])); }
    }
};
}
struct MegaParams {
    const float* in[29];
    float* out;
    unsigned* ctl;
    bf16_t *WinN, *WinT, *Wout, *Wqkv, *Wo, *Wup, *Wdn, *Wr;
    bf16_t* xb; float* rstd; float* ipfp;
    bf16_t *P1, *PT;
    bf16_t *act, *ybuf;
    bf16_t* Yb;
    bf16_t* dA; bf16_t* hB;
    int* lists; float* slot_rs; float* slot_gw;
    int ph_lo, ph_hi; unsigned prep_mask; int pad;
};
#define CTL_CNT(l) (XCD_BAR_WORDS + 32 * (l))
#define CTL_QUEUE (XCD_BAR_WORDS + 64)
#define CTL_KMAX 3584
#define MEGA_LDS_BYTES (gm::STAGE_BYTES + 16384)
#define MISC_OFF gm::STAGE_BYTES

DI float4 ld_nt4(const float* q) { const f32x4 v = __builtin_nontemporal_load((const f32x4*)q); return make_float4(v[0], v[1], v[2], v[3]); }
DI void prep_group4(LAS float* tl, const float* src, int ldsrc, int col0, int k0, const float* gain, float scale, bf16_t* dst, int K, int row0, int ncols = 64) {
    const int tid = opaque_tid();
    {
        const int kk = tid >> 4, c4 = (tid & 15) * 4;
        float4 v[8];
        if (c4 < ncols) {
#pragma unroll
            for (int q = 0; q < 8; ++q) v[q] = ld_nt4(src + (size_t)(k0 + kk + 32 * q) * ldsrc + col0 + c4);
#pragma unroll
            for (int q = 0; q < 8; ++q) { const int k = kk + 32 * q; const float g = (gain ? gain[k0 + k] : 1.0f) * scale;
                tl[k * 65 + c4 + 0] = v[q].x * g; tl[k * 65 + c4 + 1] = v[q].y * g; tl[k * 65 + c4 + 2] = v[q].z * g; tl[k * 65 + c4 + 3] = v[q].w * g; }
        }
    }
    __syncthreads();
    {
        const int n = tid >> 3, k8 = tid & 7;
        if (n < ncols)
#pragma unroll
        for (int q = 0; q < 4; ++q) { const int ks = (k8 + 8 * q) * 8;
            float v[8];
#pragma unroll
            for (int j = 0; j < 8; ++j) v[j] = tl[(ks + j) * 65 + n];
            u32x4 w; w.x = cvt_pk_bf16(v[0], v[1]); w.y = cvt_pk_bf16(v[2], v[3]); w.z = cvt_pk_bf16(v[4], v[5]); w.w = cvt_pk_bf16(v[6], v[7]);
            *(u32x4*)(dst + (size_t)(row0 + n) * K + k0 + ks) = w; }
    }
    __syncthreads();
}
#define MOE_PREP_GROUPS 6144
#define AUX_PREP_GROUPS 320
DI void moe_prep_group(const MegaParams& p, LAS float* tl, int g) {
    if (g < 4096) { const int mat = g >> 6, rt = (g >> 2) & 15, kq = g & 3, r0 = rt * 64, pn = r0 >> 8, wc = (r0 & 255) >> 6;
        const float* src = p.in[26] + (size_t)mat * 1024 * 1024; const float* gn = p.in[2] + (mat >> 5) * D_; bf16_t* dst = p.Wup + (size_t)mat * 1024 * 1024;
        prep_group4(tl, src, 1024, 128 * pn + 32 * wc, kq * 256, gn, 1.0f, dst, 1024, r0, 32);
        prep_group4(tl, src, 1024, 512 + 128 * pn + 32 * wc, kq * 256, gn, 1.0f, dst, 1024, r0 + 32, 32); }
    else { const int h = g - 4096, mat = h >> 5, rt = (h >> 1) & 15, kq = h & 1;
        prep_group4(tl, p.in[27] + (size_t)mat * 512 * 1024, 1024, rt * 64, kq * 256, nullptr, 1.0f, p.Wdn + (size_t)mat * 1024 * 512, 512, rt * 64); }
}
DI void aux_prep_group(const MegaParams& p, LAS float* tl, int t) {
    if (t < 64) { const int rt = t >> 2, kq = t & 3; prep_group4(tl, p.in[4], 1024, rt * 64, kq * 256, nullptr, 1.0f, p.Wout, 1024, rt * 64); }
    else if (t < 256) { const int u = t - 64, rt = u >> 2, kq = u & 3, r0 = rt * 64; prep_group4(tl, p.in[15], 3072, r0, kq * 256, p.in[1] + D_, r0 < 1024 ? 0.125f : 1.0f, p.Wqkv, 1024, r0); }
    else { const int u = t - 256, rt = u >> 2, kq = u & 3; prep_group4(tl, p.in[16], 1024, rt * 64, kq * 256, nullptr, 1.0f, p.Wo, 1024, rt * 64); }
}
DI void phase_prep(const MegaParams& p, LAS unsigned char* lds) {
    LAS float* tl = (LAS float*)lds;
    const int G = gridDim.x, bid = blockIdx.x, tid = opaque_tid();
    const unsigned mask = p.prep_mask;
    const float KS = 0.08838834764831845f;
    if (mask & 1u) for (int t = bid; t < 48 * 4; t += G) { const int rt = t >> 2, kq = t & 3, r0 = rt * 64;
        prep_group4(tl, p.in[3], PROJ_N, r0, kq * 256, p.in[1], (r0 >= 1536 && r0 < 2048) ? KS : 1.0f, p.WinN, 1024, r0); }
    if (mask & 4u) for (int t = bid; t < 16 * 4; t += G) { const int rt = t >> 2, kq = t & 3; prep_group4(tl, p.in[4], 1024, rt * 64, kq * 256, nullptr, 1.0f, p.Wout, 1024, rt * 64); }
    if (mask & 8u) for (int t = bid; t < 48 * 4; t += G) { const int rt = t >> 2, kq = t & 3, r0 = rt * 64;
        prep_group4(tl, p.in[15], 3072, r0, kq * 256, p.in[1] + D_, r0 < 1024 ? 0.125f : 1.0f, p.Wqkv, 1024, r0); }
    if (mask & 16u) for (int t = bid; t < 16 * 4; t += G) { const int rt = t >> 2, kq = t & 3; prep_group4(tl, p.in[16], 1024, rt * 64, kq * 256, nullptr, 1.0f, p.Wo, 1024, rt * 64); }
    if (mask & 32u) for (int g = bid; g < MOE_PREP_GROUPS; g += G) moe_prep_group(p, tl, g);
    if (mask & 128u) {
        for (int i = bid * 512 + tid; i < 2 * 48 * 1024; i += G * 512) { const int l = i / (48 * 1024), r = (i / 1024) % 48, k = i & 1023; float v = 0.f;
            if (r < 4) v = p.in[22][(size_t)l * 1024 * 4 + k * 4 + r]; else if (r < 36) v = p.in[24][(size_t)l * 1024 * 32 + k * 32 + (r - 4)];
            p.Wr[i] = (bf16_t)(cvt_pk_bf16(v * p.in[2][l * D_ + k], 0.f) & 0xffffu); }
    }
    if (mask & 256u) {
        LAS float* wg = (LAS float*)lds;
        __syncthreads();
        for (int i = tid; i < 8192; i += 512) { const int j = i >> 10, k = i & 1023; wg[i] = p.in[3][(size_t)k * PROJ_N + 3072 + j] * p.in[1][k]; }
        __syncthreads();
        const int wave = tid >> 6, lane = tid & 63; const float* x = p.in[0];
        for (int rbase = bid * 128 + wave * 16; rbase < T_; rbase += G * 128) {
        float4 nv[2][4];
        {
#pragma unroll
            for (int q = 0; q < 2; ++q)
#pragma unroll
                for (int i = 0; i < 4; ++i) nv[q][i] = ld_nt4(x + (size_t)(rbase + q) * D_ + (lane + 64 * i) * 4);
        }
        for (int r4 = 0; r4 < 16; r4 += 2) {
            float4 v[2][4]; float ss[2]; float dot[2][8];
#pragma unroll
            for (int q = 0; q < 2; ++q)
#pragma unroll
                for (int i = 0; i < 4; ++i) v[q][i] = nv[q][i];
            if (r4 + 2 < 16) {
#pragma unroll
                for (int q = 0; q < 2; ++q)
#pragma unroll
                    for (int i = 0; i < 4; ++i) nv[q][i] = ld_nt4(x + (size_t)(rbase + r4 + 2 + q) * D_ + (lane + 64 * i) * 4);
            }
#pragma unroll
            for (int q = 0; q < 2; ++q) { ss[q] = 0.f;
#pragma unroll
                for (int j = 0; j < 8; ++j) dot[q][j] = 0.f; }
#pragma unroll
            for (int i = 0; i < 4; ++i) {
#pragma unroll
                for (int q = 0; q < 2; ++q) ss[q] += v[q][i].x * v[q][i].x + v[q][i].y * v[q][i].y + v[q][i].z * v[q][i].z + v[q][i].w * v[q][i].w;
#pragma unroll
                for (int j = 0; j < 8; ++j) { const f32x4 g4 = *(const LAS f32x4*)(wg + j * 1024 + (lane + 64 * i) * 4);
#pragma unroll
                    for (int q = 0; q < 2; ++q) dot[q][j] += v[q][i].x * g4[0] + v[q][i].y * g4[1] + v[q][i].z * g4[2] + v[q][i].w * g4[3]; }
            }
#pragma unroll
            for (int q = 0; q < 2; ++q) {
                ss[q] = wave_sum_uniform(ss[q]);
#pragma unroll
                for (int j = 0; j < 8; ++j) dot[q][j] = wave_sum_uniform(dot[q][j]);
                const int row = rbase + r4 + q;
                const float rs = rsqrtf(ss[q] * (1.0f / D_) + EPS_);
#pragma unroll
                for (int i = 0; i < 4; ++i) { u32x2 w; w.x = cvt_pk_bf16(v[q][i].x * rs, v[q][i].y * rs); w.y = cvt_pk_bf16(v[q][i].z * rs, v[q][i].w * rs); *(u32x2*)(p.xb + (size_t)row * D_ + (lane + 64 * i) * 4) = w; }
                if (lane == 0) { p.rstd[row] = rs;
                    f32x4 a = {dot[q][0] * rs, dot[q][1] * rs, dot[q][2] * rs, dot[q][3] * rs}, b = {dot[q][4] * rs, dot[q][5] * rs, dot[q][6] * rs, dot[q][7] * rs};
                    *(f32x4*)(p.ipfp + (size_t)row * 8) = a; *(f32x4*)(p.ipfp + (size_t)row * 8 + 4) = b; }
            }
        }
        }
        __syncthreads();
    }
}

DI void phase_router(const MegaParams& p, LAS unsigned char* lds, const bf16_t* dlt, const bf16_t* Wr, const float* bg, const float* be, unsigned* gcnt) {
    LAS float* lg = (LAS float*)lds;
    LAS float* rsl = (LAS float*)(lds + 8 * 16 * 48 * 4);
    LAS int* lcnt = (LAS int*)(lds + 8 * 16 * 48 * 4 + 8 * 16 * 4);
    LAS int* lbase = lcnt + 32;
    const int tid = opaque_tid(), wave = tid >> 6, lane = tid & 63, fr = lane & 15, g = lane >> 4;
    LAS unsigned char* wl = lds + 25600;
    __syncthreads();
    for (int i = tid; i < 48 * 128; i += 512) { const int r = i >> 7, c8 = (i & 127) * 8; *(LAS u32x4*)(wl + (r * 1032 + c8) * 2) = *(const u32x4*)(Wr + (size_t)r * D_ + c8); }
    __syncthreads();
    for (int base = blockIdx.x * 128; base < T_; base += gridDim.x * 128) {
        if (tid < 32) lcnt[tid] = 0;
        const int r0 = base + wave * 16;
        f32x4 acc[3];
#pragma unroll
        for (int n = 0; n < 3; ++n) acc[n] = (f32x4){0.f, 0.f, 0.f, 0.f};
        float ss = 0.f;
        const float inv_rs = 1.0f / p.rstd[r0 + fr];
        const bf16_t* __restrict__ dp = dlt + (size_t)(r0 + fr) * D_ + 8 * g;
        bf16_t* xo = p.xb + (size_t)(r0 + fr) * D_ + 8 * g;
        const LAS unsigned char* wp = wl + (fr * 1032 + 8 * g) * 2;
#pragma unroll 8
        for (int kk = 0; kk < 32; ++kk) {
            float4 a, b;
            { const u32x4 hv = *(const u32x4*)(xo + 32 * kk); a = make_float4(bf_lo(hv.x) * inv_rs, bf_hi(hv.x) * inv_rs, bf_lo(hv.y) * inv_rs, bf_hi(hv.y) * inv_rs); b = make_float4(bf_lo(hv.z) * inv_rs, bf_hi(hv.z) * inv_rs, bf_lo(hv.w) * inv_rs, bf_hi(hv.w) * inv_rs); }
            { const u32x4 dv = *(const u32x4*)(dp + 32 * kk); a.x += bf_lo(dv.x); a.y += bf_hi(dv.x); a.z += bf_lo(dv.y); a.w += bf_hi(dv.y); b.x += bf_lo(dv.z); b.y += bf_hi(dv.z); b.z += bf_lo(dv.w); b.w += bf_hi(dv.w); }
            ss += a.x * a.x + a.y * a.y + a.z * a.z + a.w * a.w + b.x * b.x + b.y * b.y + b.z * b.z + b.w * b.w;
            u32x4 pk; pk.x = cvt_pk_bf16(a.x, a.y); pk.y = cvt_pk_bf16(a.z, a.w); pk.z = cvt_pk_bf16(b.x, b.y); pk.w = cvt_pk_bf16(b.z, b.w);
            *(u32x4*)(xo + 32 * kk) = pk;
            const bf16x8 af = __builtin_bit_cast(bf16x8, pk);
#pragma unroll
            for (int n = 0; n < 3; ++n) { const bf16x8 bfr = *(const LAS bf16x8*)(wp + (n * 16 * 1032 + 32 * kk) * 2); acc[n] = __builtin_amdgcn_mfma_f32_16x16x32_bf16(af, bfr, acc[n], 0, 0, 0); }
        }
        ss += __shfl_xor(ss, 16); ss += __shfl_xor(ss, 32);
        const float rs = rsqrtf(ss * (1.0f / D_) + EPS_);
        if (g == 0) { p.rstd[r0 + fr] = rs; rsl[wave * 16 + fr] = rs; }
        __syncthreads();
#pragma unroll
        for (int n = 0; n < 3; ++n) { const int col = 16 * n + fr; const float bias = col < 4 ? bg[col] : (col < 36 ? be[col - 4] : 0.f);
#pragma unroll
            for (int r = 0; r < 4; ++r) lg[(wave * 16 + 4 * g + r) * 48 + col] = acc[n][r] * rsl[wave * 16 + 4 * g + r] + bias; }
        __syncthreads();
        int x0 = 0, x1 = 0, p0 = 0, p1 = 0; float w0 = 0.f, w1 = 0.f;
        if (lane < 16) {
            const LAS float* L = lg + (wave * 16 + lane) * 48;
            int gi = 0; float gmx = L[0];
            for (int j = 1; j < 4; ++j) if (L[j] > gmx) { gmx = L[j]; gi = j; }
            float gs = 0.f; for (int j = 0; j < 4; ++j) gs += expf(L[j] - gmx);
            const float gw = 1.0f / gs;
            const LAS float* E = L + 4 + gi * 8;
            int i0 = 0; float v0 = E[0];
            for (int j = 1; j < 8; ++j) if (E[j] > v0) { v0 = E[j]; i0 = j; }
            int i1 = -1; float v1 = -INFINITY;
            for (int j = 0; j < 8; ++j) if (j != i0 && E[j] > v1) { v1 = E[j]; i1 = j; }
            const float e1 = expf(v1 - v0);
            w0 = gw / (1.0f + e1); w1 = gw * e1 / (1.0f + e1);
            x0 = gi * 8 + i0; x1 = gi * 8 + i1;
            p0 = atomicAdd((int*)&lcnt[x0], 1); p1 = atomicAdd((int*)&lcnt[x1], 1);
        }
        __syncthreads();
        if (tid < 32) { const int c = lcnt[tid]; lbase[tid] = c ? (int)atomicAdd(&gcnt[tid], (unsigned)c) : 0; }
        __syncthreads();
        if (lane < 16) {
            const int t = r0 + lane;
            const size_t i0 = (size_t)x0 * T_ + lbase[x0] + p0, i1 = (size_t)x1 * T_ + lbase[x1] + p1; const float rsv = rsl[wave * 16 + lane];
            p.lists[i0] = 2 * t; p.lists[i1] = 2 * t + 1; p.slot_rs[i0] = rsv; p.slot_rs[i1] = rsv; p.slot_gw[i0] = w0; p.slot_gw[i1] = w1;
        }
        __syncthreads();
    }
}

struct MoeTables { LAS int* cnt; LAS int* tp; LAS int* poff; int ntiles; };
DI MoeTables moe_tables(LAS unsigned char* misc, const unsigned* gcnt) {
    MoeTables t; t.cnt = (LAS int*)misc; t.tp = t.cnt + 32; t.poff = t.tp + 33;
    __syncthreads();
    if (threadIdx.x < 32) t.cnt[threadIdx.x] = (int)__hip_atomic_load(gcnt + threadIdx.x, __ATOMIC_RELAXED, __HIP_MEMORY_SCOPE_AGENT);
    __syncthreads();
    if (threadIdx.x == 0) { int r = 0; for (int e = 0; e < 32; ++e) { const int c = t.cnt[e]; t.tp[e] = r; t.poff[e] = r * 256; r += (c + 255) >> 8; } t.tp[32] = r; }
    __syncthreads();
    t.ntiles = t.tp[32];
    return t;
}
struct MoeUpSched {
    static constexpr bool GATHER = true;
    const bf16_t* xb; const bf16_t* W; const int* lists; MoeTables tb; int G, c; int tid16;
    DI bool next(int i, gm::Unit& u) const {
        const int L = i * G + c; if (L >= tb.ntiles * 4) return false;
        const int mtile = L >> 2, pn = L & 3; int e = 0;
        for (int j = 1; j < 32; ++j) if (tb.tp[j] <= mtile) e = j;
        e = __builtin_amdgcn_readfirstlane(e);
        const int mt = __builtin_amdgcn_readfirstlane(mtile - tb.tp[e]), cnt = __builtin_amdgcn_readfirstlane(tb.cnt[e]);
        u.aB = (const char*)xb; u.bB = (const char*)W + ((size_t)e * 1024 + (size_t)pn * 256) * 1024 * 2; u.pm = mtile; u.pn = pn; u.e = e; u.cnt = cnt - mt * 256; u.mt = mt;
        return true;
    }
    DI void va_direct(const gm::Unit& u, unsigned (&va)[2][2]) const {
        int tk[2][2];
#pragma unroll
        for (int q = 0; q < 2; ++q) { int R, C; gm::stage_rc(opaque_tid() * 16 + q * 8192, R, C); R = (R & ~15) + gm::rho16(R & 15);
#pragma unroll
            for (int h = 0; h < 2; ++h) { int r = h * 128 + R; r = r < u.cnt ? r : u.cnt - 1; tk[h][q] = lists[(size_t)u.e * T_ + u.mt * 256 + r]; } }
#pragma unroll
        for (int q = 0; q < 2; ++q) { int R, C; gm::stage_rc(opaque_tid() * 16 + q * 8192, R, C);
#pragma unroll
            for (int h = 0; h < 2; ++h) va[h][q] = (unsigned)((tk[h][q] >> 1) * 1024 + C) * 2u; }
    }
    DI void side_issue(LAS unsigned char* side, const gm::Unit& nx, int lane) const {
        __builtin_amdgcn_global_load_lds((const unsigned*)(lists + (size_t)nx.e * T_ + nx.mt * 256 + lane * 4), (LAS unsigned*)side, 16, 0, 0);
    }
    DI void fill_va(LAS unsigned char* side, const gm::Unit& u, unsigned (&va)[2][2], int h, int tidr) const {
        const LAS int* sl = (const LAS int*)side;
#pragma unroll
        for (int q = 0; q < 2; ++q) { int R, C; gm::stage_rc(tidr * 16 + q * 8192, R, C); R = (R & ~15) + gm::rho16(R & 15);
            int r = h * 128 + R; r = r < u.cnt ? r : u.cnt - 1; const int tk = sl[r]; va[h][q] = (unsigned)((tk >> 1) * 1024 + C) * 2u; }
    }
};
struct MoeDownSched {
    static constexpr bool GATHER = false;
    const bf16_t* act; const bf16_t* W; MoeTables tb; int G, c; int tid16;
    DI bool next(int i, gm::Unit& u) const {
        const int L = i * G + c; if (L >= tb.ntiles * 4) return false;
        const int mtile = L >> 2, pn = L & 3; int e = 0;
        for (int j = 1; j < 32; ++j) if (tb.tp[j] <= mtile) e = j;
        e = __builtin_amdgcn_readfirstlane(e);
        const int mt = __builtin_amdgcn_readfirstlane(mtile - tb.tp[e]), cnt = __builtin_amdgcn_readfirstlane(tb.cnt[e]);
        u.aB = (const char*)act + (size_t)mtile * 256 * 512 * 2; u.bB = (const char*)W + ((size_t)e * 1024 + (size_t)pn * 256) * 512 * 2; u.pm = mtile; u.pn = pn; u.e = e; u.cnt = cnt - mt * 256; u.mt = mt;
        return true;
    }
    DI void va_direct(const gm::Unit&, unsigned (&va)[2][2]) const { int R, C; gm::stage_rc(opaque_tid() * 16, R, C); R = (R & ~15) + gm::rho16(R & 15); const unsigned v = (unsigned)(R * 512 + C) * 2u; va[0][0] = v; va[0][1] = v; va[1][0] = v; va[1][1] = v; }
    GM_NO_SCHED_SIDE
};
struct EpiSwiglu {
    static constexpr bool PERM = true;
    bf16_t* act; const float* slot_rs; LAS int* tp;
    DI void side_issue(LAS unsigned char* side, const gm::Unit& u, int lane) const {
        __builtin_amdgcn_global_load_lds((const unsigned*)(slot_rs + (size_t)u.e * T_ + u.mt * 256 + lane * 4), (LAS unsigned*)(side + 1024), 16, 0, 0);
    }
    DI void operator()(const f32x4 (&acc)[2][2][4][2], const gm::Unit& u, int wr, int wc, int fr, int fq, LAS unsigned char* side) const {
        const LAS float* srow = (const LAS float*)(side + 1024);
        int fro = fr, fqo = fq; asm volatile("" : "+v"(fro), "+v"(fqo));
        float srs[8];
#pragma unroll
        for (int q = 0; q < 8; ++q) { const int rl = (q >> 2) * 128 + wr * 64 + (q & 3) * 16 + gm::rho16(fro); const int rr = rl < u.cnt ? rl : u.cnt - 1; srs[q] = srow[rr]; }
#pragma unroll
        for (int ai = 0; ai < 2; ++ai)
#pragma unroll
            for (int m = 0; m < 4; ++m) {
                const int rl = ai * 128 + wr * 64 + m * 16 + gm::rho16(fro);
                const float s = srs[ai * 4 + m];
                float o[8];
#pragma unroll
                for (int n = 0; n < 2; ++n)
#pragma unroll
                    for (int j = 0; j < 4; ++j) { const float a = acc[ai][0][m][n][j] * s, b = acc[ai][1][m][n][j] * s; o[4 * n + j] = a * b * __builtin_amdgcn_rcpf(1.0f + __expf(-a)); }
                u32x4 w; w.x = cvt_pk_bf16(o[0], o[1]); w.y = cvt_pk_bf16(o[2], o[3]); w.z = cvt_pk_bf16(o[4], o[5]); w.w = cvt_pk_bf16(o[6], o[7]);
                __builtin_nontemporal_store(w, (u32x4*)(act + (size_t)(u.pm * 256 + rl) * 512 + u.pn * 128 + wc * 32 + 8 * fqo));
            }
    }
};
struct EpiMoeDown {
    static constexpr bool PERM = true;
    bf16_t* ybuf; const int* lists; const float* slot_gw; LAS int* tp;
    DI void side_issue(LAS unsigned char* side, const gm::Unit& u, int lane) const {
        const size_t li = (size_t)u.e * T_ + u.mt * 256 + lane * 4;
        __builtin_amdgcn_global_load_lds((const unsigned*)(lists + li), (LAS unsigned*)(side + 1024), 16, 0, 0);
        __builtin_amdgcn_global_load_lds((const unsigned*)(slot_gw + li), (LAS unsigned*)(side + 2048), 16, 0, 0);
    }
    DI void operator()(const f32x4 (&acc)[2][2][4][2], const gm::Unit& u, int wr, int wc, int fr, int fq, LAS unsigned char* side) const {
        const LAS int* stk = (const LAS int*)(side + 1024); const LAS float* sgwp = (const LAS float*)(side + 2048);
        int fro = fr, fqo = fq; asm volatile("" : "+v"(fro), "+v"(fqo));
        int tks[8]; float sgw[8];
#pragma unroll
        for (int q = 0; q < 8; ++q) { const int rl = (q >> 2) * 128 + wr * 64 + (q & 3) * 16 + gm::rho16(fro); const int rr = rl < u.cnt ? rl : u.cnt - 1; tks[q] = stk[rr]; sgw[q] = sgwp[rr]; }
        const int coff = u.pn * 256 + wc * 64 + 32 * (fro & 1) + 8 * fqo;
#pragma unroll
        for (int ai = 0; ai < 2; ++ai)
#pragma unroll
            for (int m = 0; m < 4; ++m) {
                const float s = sgw[ai * 4 + m]; const int tk = tks[ai * 4 + m];
                const int tkp = (int)gm::dpp_ror8((unsigned)tk);
                u32x4 a, b; gm::xchg_lines(gm::pack_piece(acc[ai][0][m][0] * s, acc[ai][0][m][1] * s), gm::pack_piece(acc[ai][1][m][0] * s, acc[ai][1][m][1] * s), fro, a, b);
                const int rb = ai * 128 + wr * 64 + m * 16 + (fro >> 1);
                const int tkA = (fro & 1) == 0 ? tk : tkp, tkB = (fro & 1) == 0 ? tkp : tk;
                if (rb < u.cnt) __builtin_nontemporal_store(a, (u32x4*)(ybuf + (size_t)tkA * 1024 + coff));
                if (rb + 8 < u.cnt) __builtin_nontemporal_store(b, (u32x4*)(ybuf + (size_t)tkB * 1024 + coff));
            }
    }
};

template <int MODE>
DI void phase_combine(const MegaParams& p, void* hout_, const float* gfin) {
    float* hout = (float*)hout_;
    const int tid_ = opaque_tid(); const int wave = tid_ >> 6, lane = tid_ & 63;
    u32x4 nx[2][3];
    auto issue = [&](int r) {
#pragma unroll
        for (int i = 0; i < 2; ++i) { const int c = (lane + 64 * i) * 8;
            nx[i][0] = *(const u32x4*)(p.xb + (size_t)r * D_ + c); nx[i][1] = __builtin_nontemporal_load((const u32x4*)(p.ybuf + (size_t)(2 * r) * D_ + c)); nx[i][2] = __builtin_nontemporal_load((const u32x4*)(p.ybuf + (size_t)(2 * r + 1) * D_ + c)); } };
    const int rstep = gridDim.x * 8;
    int row = blockIdx.x * 8 + wave;
    if (row < T_) issue(row);
    for (; row < T_; row += rstep) {
        float v[16]; float ss = 0.f;
        u32x4 cu[2][3];
#pragma unroll
        for (int i = 0; i < 2; ++i)
#pragma unroll
            for (int q = 0; q < 3; ++q) cu[i][q] = nx[i][q];
        if (row + rstep < T_) issue(row + rstep);
#pragma unroll
        for (int i = 0; i < 2; ++i) {
            const u32x4 hv = cu[i][0], a = cu[i][1], b = cu[i][2];
            v[8 * i + 0] = bf_lo(hv.x) + (bf_lo(a.x) + bf_lo(b.x)); v[8 * i + 1] = bf_hi(hv.x) + (bf_hi(a.x) + bf_hi(b.x));
            v[8 * i + 2] = bf_lo(hv.y) + (bf_lo(a.y) + bf_lo(b.y)); v[8 * i + 3] = bf_hi(hv.y) + (bf_hi(a.y) + bf_hi(b.y));
            v[8 * i + 4] = bf_lo(hv.z) + (bf_lo(a.z) + bf_lo(b.z)); v[8 * i + 5] = bf_hi(hv.z) + (bf_hi(a.z) + bf_hi(b.z));
            v[8 * i + 6] = bf_lo(hv.w) + (bf_lo(a.w) + bf_lo(b.w)); v[8 * i + 7] = bf_hi(hv.w) + (bf_hi(a.w) + bf_hi(b.w));
        }
#pragma unroll
        for (int j = 0; j < 16; ++j) ss += v[j] * v[j];
        ss = wave_sum_uniform(ss);
        const float rs = rsqrtf(ss * (1.0f / D_) + EPS_);
#pragma unroll
        for (int i = 0; i < 2; ++i) {
            const int c = (lane + 64 * i) * 8;
            if (MODE == 0) {
                u32x4 w; w.x = cvt_pk_bf16(v[8 * i] * rs, v[8 * i + 1] * rs); w.y = cvt_pk_bf16(v[8 * i + 2] * rs, v[8 * i + 3] * rs); w.z = cvt_pk_bf16(v[8 * i + 4] * rs, v[8 * i + 5] * rs); w.w = cvt_pk_bf16(v[8 * i + 6] * rs, v[8 * i + 7] * rs);
                *(u32x4*)(p.xb + (size_t)row * D_ + c) = w;
            } else {
                const float4 g0 = *(const float4*)(gfin + c), g1 = *(const float4*)(gfin + c + 4);
                __builtin_nontemporal_store((f32x4){v[8 * i] * rs * g0.x, v[8 * i + 1] * rs * g0.y, v[8 * i + 2] * rs * g0.z, v[8 * i + 3] * rs * g0.w}, (f32x4*)(hout + (size_t)row * D_ + c));
                __builtin_nontemporal_store((f32x4){v[8 * i + 4] * rs * g1.x, v[8 * i + 5] * rs * g1.y, v[8 * i + 6] * rs * g1.z, v[8 * i + 7] * rs * g1.w}, (f32x4*)(hout + (size_t)row * D_ + c + 4));
            }
        }
        if (MODE == 0 && lane == 0) p.rstd[row] = rs;
    }
}
#define LAMBDA_INIT_F 0.35550906759096926f
#define ATT_KSTR 136
#define ATT_VSTR 160
#define ATT_KBYTES (64 * ATT_KSTR * 2)
#define ATT_VBYTES (64 * ATT_VSTR * 2)
#define MFMA32(a, b, c) __builtin_amdgcn_mfma_f32_32x32x16_bf16((a), (b), (c), 0, 0, 0)
DI bf16x8 pack8(float a0, float a1, float a2, float a3, float a4, float a5, float a6, float a7) {
    u32x4 p; p.x = cvt_pk_bf16(a0, a1); p.y = cvt_pk_bf16(a2, a3); p.z = cvt_pk_bf16(a4, a5); p.w = cvt_pk_bf16(a6, a7);
    return __builtin_bit_cast(bf16x8, p);
}
typedef short tr4_t __attribute__((ext_vector_type(4)));
struct AttnPre { bf16x8 qf[4]; u32x4 kr0, kr1, vr0, vr1; };
DI void attn_issue(const MegaParams& p, int b, int h, int qb, AttnPre& R) {
    const int tid = opaque_tid(), wid = __builtin_amdgcn_readfirstlane(tid >> 6), lane = tid & 63, l31 = lane & 31, hh = lane >> 5;
    const int comp = wid >> 2, rg = wid & 3, nkt = 2 * qb + 2, q0 = qb * 128 + rg * 32;
    const size_t tokbase = (size_t)b * S_;
    const bf16_t* qp = p.P1 + (tokbase + q0 + l31) * 3072 + h * 128 + comp * 64 + 8 * hh;
#pragma unroll
    for (int ks = 0; ks < 4; ++ks) R.qf[ks] = *(const bf16x8*)(qp + 16 * ks);
    const int skey = tid >> 3, sseg = tid & 7;
    const bf16_t* kg0 = p.P1 + (tokbase + (size_t)(nkt - 1) * 64 + skey) * 3072 + 1024 + h * 128 + sseg * 8;
    R.kr0 = *(const u32x4*)(kg0); R.kr1 = *(const u32x4*)(kg0 + 64); R.vr0 = *(const u32x4*)(kg0 + 1024); R.vr1 = *(const u32x4*)(kg0 + 1024 + 64);
}
DI void attn_unit(const MegaParams& p, LAS unsigned char* lds, LAS unsigned char* misc, int b, int h, int qb, float lam, int force_lim, AttnPre& pre, bool has_next, int nb, int nh, int nqb) {
    const int tid = opaque_tid(), wid = __builtin_amdgcn_readfirstlane(tid >> 6), lane = tid & 63, l31 = lane & 31, hh = lane >> 5;
    const int comp = wid >> 2, rg = wid & 3, l15 = lane & 15, eh = (lane >> 4) & 1;
    const bf16_t* QK = p.P1;
    const float LOG2E = 1.4426950408889634f;
    const int q0 = qb * 128 + rg * 32, qc = q0 >> 6, Q0 = qc * 64, nkt = 2 * qb + 2;
    const size_t tokbase = (size_t)b * S_;
    const float slope = exp2f(-(float)(h + 1));
    LAS unsigned char* kbuf = lds; LAS unsigned char* vbuf = lds + 2 * ATT_KBYTES;
    LAS float* gl = (LAS float*)(misc + 4096);
    LAS unsigned char* qbuf = lds + 2 * ATT_KBYTES + 2 * ATT_VBYTES + wid * 4352 + lane * 16;
#pragma unroll
    for (int ks = 0; ks < 4; ++ks) *(LAS bf16x8*)(qbuf + ks * 1024) = pre.qf[ks];
    float qn;
    { float s2 = 0.f;
#pragma unroll
      for (int ks = 0; ks < 4; ++ks) { const u32x4 w = __builtin_bit_cast(u32x4, pre.qf[ks]);
          s2 += bf_lo(w.x) * bf_lo(w.x) + bf_hi(w.x) * bf_hi(w.x) + bf_lo(w.y) * bf_lo(w.y) + bf_hi(w.y) * bf_hi(w.y) + bf_lo(w.z) * bf_lo(w.z) + bf_hi(w.z) * bf_hi(w.z) + bf_lo(w.w) * bf_lo(w.w) + bf_hi(w.w) * bf_hi(w.w); }
      s2 += __shfl_xor(s2, 32); qn = __builtin_amdgcn_sqrtf(s2) * 1.001f; }
    const unsigned* kmx = p.ctl + CTL_KMAX + ((b * 8 + h) * 4 + comp * 2);
    const float kb = __builtin_amdgcn_sqrtf(__uint_as_float(__hip_atomic_load(kmx, __ATOMIC_RELAXED, __HIP_MEMORY_SCOPE_AGENT)) + __uint_as_float(__hip_atomic_load(kmx + 1, __ATOMIC_RELAXED, __HIP_MEMORY_SCOPE_AGENT))) * 1.02f;
    const float qk_ub = qn * kb;
    LAS int* votes = (LAS int*)(misc + 3072);
    const int skey = tid >> 3, sseg = tid & 7;
    const bf16_t* kg = QK + (tokbase + skey) * 3072 + 1024 + h * 128 + sseg * 8;
    const bf16_t* vg = QK + (tokbase + skey) * 3072 + 2048 + h * 128 + sseg * 8;
    const int klds = (skey * ATT_KSTR + sseg * 8) * 2, vlds = (skey * ATT_VSTR + sseg * 8) * 2;
    *(LAS u32x4*)(kbuf + klds) = pre.kr0; *(LAS u32x4*)(kbuf + klds + 128) = pre.kr1;
    *(LAS u32x4*)(vbuf + vlds) = pre.vr0; *(LAS u32x4*)(vbuf + vlds + 128) = pre.vr1;
    u32x4 sa0, sa1, sa2, sa3, sb0, sb1, sb2, sb3;
    { const bf16_t* kgn = kg + (size_t)(nkt - 2) * 64 * 3072; const bf16_t* vgn = vg + (size_t)(nkt - 2) * 64 * 3072;
      sb0 = *(const u32x4*)(kgn); sb1 = *(const u32x4*)(kgn + 64); sb2 = *(const u32x4*)(vgn); sb3 = *(const u32x4*)(vgn + 64); }
    __syncthreads();
    f32x16 O[4];
#pragma unroll
    for (int et = 0; et < 4; ++et)
#pragma unroll
        for (int i = 0; i < 16; ++i) O[et][i] = 0.f;
    float m = -1e30f, l = 0.f;
    int kt = nkt - 1, it = 0;
    for (;;) {
        bool stop;
        {
        const int cur = it & 1;
        if (kt >= 2) { const bf16_t* kgn = kg + (size_t)(kt - 2) * 64 * 3072; const bf16_t* vgn = vg + (size_t)(kt - 2) * 64 * 3072;
            sa0 = *(const u32x4*)(kgn); sa1 = *(const u32x4*)(kgn + 64); sa2 = *(const u32x4*)(vgn); sa3 = *(const u32x4*)(vgn + 64); }
        if (kt <= qc) {
            LAS unsigned char* kb = kbuf + cur * ATT_KBYTES; LAS unsigned char* vb = vbuf + cur * ATT_VBYTES;
            const bool diag = (kt == qc);
            bf16x8 qfr[4];
#pragma unroll
            for (int ks = 0; ks < 4; ++ks) qfr[ks] = *(const LAS bf16x8*)(qbuf + ks * 1024);
            f32x16 s[2];
#pragma unroll
            for (int sub = 0; sub < 2; ++sub) {
                const float kb0 = diag ? 0.f : slope * (float)(kt * 64 + 32 * sub + 4 * hh - Q0);
                const float sl = diag ? 0.f : slope;
#pragma unroll
                for (int i = 0; i < 16; ++i) s[sub][i] = kb0 + sl * (float)((i & 3) + 8 * (i >> 2));
#pragma unroll
                for (int ks = 0; ks < 4; ++ks) {
                    const bf16x8 kf = *(const LAS bf16x8*)(kb + ((32 * sub + l31) * ATT_KSTR + comp * 64 + 16 * ks + 8 * hh) * 2);
                    s[sub] = MFMA32(kf, qfr[ks], s[sub]);
                }
            }
            if (diag) {
                const float qrel2 = 2.0f * (float)(q0 - Q0 + l31);
#pragma unroll
                for (int sub = 0; sub < 2; ++sub)
#pragma unroll
                    for (int i = 0; i < 16; ++i) { const float kr = (float)(32 * sub + 4 * hh + (i & 3) + 8 * (i >> 2)); s[sub][i] += slope * fminf(kr, qrel2 - kr); }
            }
            float mt = s[0][0];
#pragma unroll
            for (int sub = 0; sub < 2; ++sub)
#pragma unroll
                for (int i = 0; i < 16; ++i) mt = fmaxf(mt, s[sub][i]);
            mt = fmaxf(mt, __shfl_xor(mt, 32));
            const bool grow = !__all(mt <= m);
            const float mn = fmaxf(m, mt);
            const float alpha = __builtin_amdgcn_exp2f((m - mn) * LOG2E);
            m = mn;
            const float mL = mn * LOG2E;
            float ps = 0.f;
#pragma unroll
            for (int sub = 0; sub < 2; ++sub)
#pragma unroll
                for (int i = 0; i < 16; ++i) { const float pv = __builtin_amdgcn_exp2f(fmaf(s[sub][i], LOG2E, -mL)); s[sub][i] = pv; ps += pv; }
            if (grow) {
                l = l * alpha;
#pragma unroll
                for (int et = 0; et < 4; ++et) O[et] = O[et] * alpha;
            }
            l += ps;
            bf16x8 pf[2][2];
#pragma unroll
            for (int sub = 0; sub < 2; ++sub)
#pragma unroll
                for (int s8 = 0; s8 < 2; ++s8)
                    pf[sub][s8] = pack8(s[sub][8 * s8], s[sub][8 * s8 + 1], s[sub][8 * s8 + 2], s[sub][8 * s8 + 3], s[sub][8 * s8 + 4], s[sub][8 * s8 + 5], s[sub][8 * s8 + 6], s[sub][8 * s8 + 7]);
#pragma unroll
            for (int et = 0; et < 4; ++et)
#pragma unroll
                for (int sub = 0; sub < 2; ++sub)
#pragma unroll
                    for (int s8 = 0; s8 < 2; ++s8) {
                        LAS unsigned char* vp = vb + ((32 * sub + 16 * s8 + 4 * hh + (l15 >> 2)) * ATT_VSTR + 32 * et + 16 * eh + 4 * (l15 & 3)) * 2;
                        const tr4_t lo = __builtin_amdgcn_ds_read_tr16_b64_v4i16((LAS tr4_t*)vp), hi = __builtin_amdgcn_ds_read_tr16_b64_v4i16((LAS tr4_t*)(vp + 8 * ATT_VSTR * 2));
                        const bf16x8 vf = __builtin_shufflevector(lo, hi, 0, 1, 2, 3, 4, 5, 6, 7);
                        O[et] = MFMA32(vf, pf[sub][s8], O[et]);
                    }
            __builtin_amdgcn_sched_barrier(0);
        }
        {
            const bool ok = (kt <= qc) && (qk_ub + slope * (float)(kt * 64 - 1 - Q0) < m - 28.0f);
            const int v = __all(ok) ? 1 : 0;
            if (lane == 0) votes[(it & 1) * 8 + wid] = v;
        }
        if (kt >= 1) {
            LAS unsigned char* kb = kbuf + (cur ^ 1) * ATT_KBYTES; LAS unsigned char* vb = vbuf + (cur ^ 1) * ATT_VBYTES;
            *(LAS u32x4*)(kb + klds) = sb0; *(LAS u32x4*)(kb + klds + 128) = sb1;
            *(LAS u32x4*)(vb + vlds) = sb2; *(LAS u32x4*)(vb + vlds + 128) = sb3;
        }
        __syncthreads();
        const LAS int* vv = votes + (it & 1) * 8;
        stop = (vv[0] & vv[1] & vv[2] & vv[3] & vv[4] & vv[5] & vv[6] & vv[7]) != 0 || kt == 0;
        if (force_lim > 0 && it + 1 >= force_lim) stop = true;
        --kt; ++it;
        }
        if (stop) break;
        {
        const int cur = it & 1;
        if (kt >= 2) { const bf16_t* kgn = kg + (size_t)(kt - 2) * 64 * 3072; const bf16_t* vgn = vg + (size_t)(kt - 2) * 64 * 3072;
            sb0 = *(const u32x4*)(kgn); sb1 = *(const u32x4*)(kgn + 64); sb2 = *(const u32x4*)(vgn); sb3 = *(const u32x4*)(vgn + 64); }
        if (kt <= qc) {
            LAS unsigned char* kb = kbuf + cur * ATT_KBYTES; LAS unsigned char* vb = vbuf + cur * ATT_VBYTES;
            const bool diag = (kt == qc);
            bf16x8 qfr[4];
#pragma unroll
            for (int ks = 0; ks < 4; ++ks) qfr[ks] = *(const LAS bf16x8*)(qbuf + ks * 1024);
            f32x16 s[2];
#pragma unroll
            for (int sub = 0; sub < 2; ++sub) {
                const float kb0 = diag ? 0.f : slope * (float)(kt * 64 + 32 * sub + 4 * hh - Q0);
                const float sl = diag ? 0.f : slope;
#pragma unroll
                for (int i = 0; i < 16; ++i) s[sub][i] = kb0 + sl * (float)((i & 3) + 8 * (i >> 2));
#pragma unroll
                for (int ks = 0; ks < 4; ++ks) {
                    const bf16x8 kf = *(const LAS bf16x8*)(kb + ((32 * sub + l31) * ATT_KSTR + comp * 64 + 16 * ks + 8 * hh) * 2);
                    s[sub] = MFMA32(kf, qfr[ks], s[sub]);
                }
            }
            if (diag) {
                const float qrel2 = 2.0f * (float)(q0 - Q0 + l31);
#pragma unroll
                for (int sub = 0; sub < 2; ++sub)
#pragma unroll
                    for (int i = 0; i < 16; ++i) { const float kr = (float)(32 * sub + 4 * hh + (i & 3) + 8 * (i >> 2)); s[sub][i] += slope * fminf(kr, qrel2 - kr); }
            }
            float mt = s[0][0];
#pragma unroll
            for (int sub = 0; sub < 2; ++sub)
#pragma unroll
                for (int i = 0; i < 16; ++i) mt = fmaxf(mt, s[sub][i]);
            mt = fmaxf(mt, __shfl_xor(mt, 32));
            const bool grow = !__all(mt <= m);
            const float mn = fmaxf(m, mt);
            const float alpha = __builtin_amdgcn_exp2f((m - mn) * LOG2E);
            m = mn;
            const float mL = mn * LOG2E;
            float ps = 0.f;
#pragma unroll
            for (int sub = 0; sub < 2; ++sub)
#pragma unroll
                for (int i = 0; i < 16; ++i) { const float pv = __builtin_amdgcn_exp2f(fmaf(s[sub][i], LOG2E, -mL)); s[sub][i] = pv; ps += pv; }
            if (grow) {
                l = l * alpha;
#pragma unroll
                for (int et = 0; et < 4; ++et) O[et] = O[et] * alpha;
            }
            l += ps;
            bf16x8 pf[2][2];
#pragma unroll
            for (int sub = 0; sub < 2; ++sub)
#pragma unroll
                for (int s8 = 0; s8 < 2; ++s8)
                    pf[sub][s8] = pack8(s[sub][8 * s8], s[sub][8 * s8 + 1], s[sub][8 * s8 + 2], s[sub][8 * s8 + 3], s[sub][8 * s8 + 4], s[sub][8 * s8 + 5], s[sub][8 * s8 + 6], s[sub][8 * s8 + 7]);
#pragma unroll
            for (int et = 0; et < 4; ++et)
#pragma unroll
                for (int sub = 0; sub < 2; ++sub)
#pragma unroll
                    for (int s8 = 0; s8 < 2; ++s8) {
                        LAS unsigned char* vp = vb + ((32 * sub + 16 * s8 + 4 * hh + (l15 >> 2)) * ATT_VSTR + 32 * et + 16 * eh + 4 * (l15 & 3)) * 2;
                        const tr4_t lo = __builtin_amdgcn_ds_read_tr16_b64_v4i16((LAS tr4_t*)vp), hi = __builtin_amdgcn_ds_read_tr16_b64_v4i16((LAS tr4_t*)(vp + 8 * ATT_VSTR * 2));
                        const bf16x8 vf = __builtin_shufflevector(lo, hi, 0, 1, 2, 3, 4, 5, 6, 7);
                        O[et] = MFMA32(vf, pf[sub][s8], O[et]);
                    }
            __builtin_amdgcn_sched_barrier(0);
        }
        {
            const bool ok = (kt <= qc) && (qk_ub + slope * (float)(kt * 64 - 1 - Q0) < m - 28.0f);
            const int v = __all(ok) ? 1 : 0;
            if (lane == 0) votes[(it & 1) * 8 + wid] = v;
        }
        if (kt >= 1) {
            LAS unsigned char* kb = kbuf + (cur ^ 1) * ATT_KBYTES; LAS unsigned char* vb = vbuf + (cur ^ 1) * ATT_VBYTES;
            *(LAS u32x4*)(kb + klds) = sa0; *(LAS u32x4*)(kb + klds + 128) = sa1;
            *(LAS u32x4*)(vb + vlds) = sa2; *(LAS u32x4*)(vb + vlds + 128) = sa3;
        }
        __syncthreads();
        const LAS int* vv = votes + (it & 1) * 8;
        stop = (vv[0] & vv[1] & vv[2] & vv[3] & vv[4] & vv[5] & vv[6] & vv[7]) != 0 || kt == 0;
        if (force_lim > 0 && it + 1 >= force_lim) stop = true;
        --kt; ++it;
        }
        if (stop) break;
    }
    l += __shfl_xor(l, 32);
    const float sc = (comp == 1 ? lam : 1.0f) / l;
    LAS float* X = (LAS float*)lds;
    LAS unsigned char* ot = lds + 2 * ATT_KBYTES + 2 * ATT_VBYTES;
    if (comp == 1) {
#pragma unroll
        for (int et = 0; et < 4; ++et)
#pragma unroll
            for (int i = 0; i < 16; ++i) { const int e = 32 * et + (i & 3) + 8 * (i >> 2) + 4 * hh; X[(rg * 128 + e) * 32 + l31] = O[et][i] * sc; }
    }
    __syncthreads();
    if (comp == 0) {
        float ssq = 0.f;
#pragma unroll
        for (int et = 0; et < 4; ++et)
#pragma unroll
            for (int i = 0; i < 16; ++i) { const int e = 32 * et + (i & 3) + 8 * (i >> 2) + 4 * hh; const float v = O[et][i] * sc - X[(rg * 128 + e) * 32 + l31]; O[et][i] = v; ssq += v * v; }
        ssq += __shfl_xor(ssq, 32);
        const float rs = rsqrtf(ssq * (1.0f / 128.0f) + EPS_) * (1.0f - LAMBDA_INIT_F);
        const LAS float* gp = gl + h * 128;
#pragma unroll
        for (int et = 0; et < 4; ++et)
#pragma unroll
            for (int gq = 0; gq < 4; ++gq) { const int e0 = 32 * et + 8 * gq + 4 * hh; const f32x4 g4 = *(const LAS f32x4*)(gp + e0);
                u32x2 w; w.x = cvt_pk_bf16(O[et][4 * gq] * rs * g4[0], O[et][4 * gq + 1] * rs * g4[1]); w.y = cvt_pk_bf16(O[et][4 * gq + 2] * rs * g4[2], O[et][4 * gq + 3] * rs * g4[3]);
                *(LAS u32x2*)(ot + ((rg * 32 + l31) * 136 + e0) * 2) = w; }
    }
    attn_issue(p, has_next ? nb : b, has_next ? nh : h, has_next ? nqb : qb, pre);
    __syncthreads();
    {
        const int row = tid >> 2, seg = tid & 3;
        bf16_t* dst = p.Yb + (tokbase + qb * 128 + row) * 1024 + h * 128 + seg * 32;
#pragma unroll
        for (int j = 0; j < 4; ++j) *(u32x4*)(dst + 8 * j) = *(const LAS u32x4*)(ot + (row * 136 + seg * 32 + 8 * j) * 2);
    }
}
DI void phase_attn(const MegaParams& p, LAS unsigned char* lds, LAS unsigned char* misc, int force_lim = 0) {
    const int tid = opaque_tid(), lane = tid & 63, G = gridDim.x;
    float a = p.in[17][lane] * p.in[18][lane], c = p.in[19][lane] * p.in[20][lane];
    for (int o = 32; o > 0; o >>= 1) { a += __shfl_xor(a, o); c += __shfl_xor(c, o); }
    const float lam = expf(a) - expf(c) + LAMBDA_INIT_F;
    __syncthreads();
    for (int i = tid; i < 1024; i += 512) ((LAS float*)(misc + 4096))[i] = p.in[21][i];
    __syncthreads();
    const int vcu = (G % 8 == 0) ? ((int)blockIdx.x % 8) * (G / 8) + (int)blockIdx.x / 8 : (int)blockIdx.x;
    const int npair = (1024 - vcu + G - 1) / G;
    auto unit_of = [&](int u, int& b, int& h, int& qb) { const int P = vcu + (u >> 1) * G; const int v = P & 255, i = P >> 8, j = v & 7, sel = (v >> 3) & 1;
        b = v >> 4; h = sel ? (i == 0 ? 1 : (i == 1 ? 6 : (i == 2 ? 2 : 5))) : (i == 0 ? 0 : (i == 1 ? 7 : (i == 2 ? 3 : 4))); qb = (u & 1) ? j : 15 - j; };
    AttnPre pre;
    if (npair > 0) { int b, h, qb; unit_of(0, b, h, qb); attn_issue(p, b, h, qb, pre); }
    for (int u = 0; u < 2 * npair; ++u) {
        int b, h, qb, nb = 0, nh = 0, nqb = 0; unit_of(u, b, h, qb);
        const bool has_next = (u + 1 < 2 * npair);
        if (has_next) unit_of(u + 1, nb, nh, nqb);
        attn_unit(p, lds, misc, b, h, qb, lam, force_lim, pre, has_next, nb, nh, nqb);
    }
}
#define MFMA16(a, b, c) __builtin_amdgcn_mfma_f32_16x16x32_bf16((a), (b), (c), 0, 0, 0)
DI float wave_scan_add(float v, int lane) {
#pragma unroll
    for (int o = 1; o < 64; o <<= 1) { const float t = __shfl_up(v, o); if (lane >= o) v += t; }
    return v;
}
DI float wave_scan_max(float v, int lane) {
#pragma unroll
    for (int o = 1; o < 64; o <<= 1) { const float t = __shfl_up(v, o); if (lane >= o) v = fmaxf(v, t); }
    return v;
}
DI float fast_rcp(float x) { return __builtin_amdgcn_rcpf(x); }
DI float fast_sigmoid(float x) { return fast_rcp(1.0f + __expf(-x)); }
DI float one_minus_exp(float t) {
    const float ser = -t * (1.0f + t * (0.5f + t * (0.16666667f + t * 0.041666668f)));
    return t > -0.125f ? ser : 1.0f - __expf(t);
}

#define LRU_XSTR 68
DI void lru_unit(const MegaParams& p, LAS unsigned char* lds, int b, int blk) {
    const int tid = opaque_tid(), wid = __builtin_amdgcn_readfirstlane(tid >> 6), lane = tid & 63, l31 = lane & 31, hh = lane >> 5;
    LAS float* xcf = (LAS float*)lds;
    LAS float* abuf = (LAS float*)(lds + 34816);
    LAS unsigned char* wrt = lds + 34816 + 32768;
    LAS unsigned char* wit = wrt + 9216;
    LAS float* agg = (LAS float*)(wit + 9216);
    LAS float* carry = agg + 1024;
    LAS float* cw = carry + 64;
    LAS float* cb = cw + 256; LAS float* brl = cb + 64; LAS float* bil = brl + 64; LAS float* cl = bil + 64;
    LAS float* ubuf = (LAS float*)(lds + 98304);
    const int c0 = blk * 64;
    __syncthreads();
    for (int i = tid; i < 4096; i += 512) { const int d = i >> 6, e = i & 63;
        const float wr = p.in[7][(size_t)blk * 4096 + i], wi = p.in[9][(size_t)blk * 4096 + i];
        *(LAS bf16_t*)(wrt + (e * 72 + d) * 2) = (bf16_t)(cvt_pk_bf16(wr, 0.f) & 0xffffu);
        *(LAS bf16_t*)(wit + (e * 72 + d) * 2) = (bf16_t)(cvt_pk_bf16(wi, 0.f) & 0xffffu); }
    if (tid < 256) cw[tid] = p.in[5][(tid >> 6) * 512 + c0 + (tid & 63)];
    if (tid < 64) { cb[tid] = p.in[6][c0 + tid]; brl[tid] = p.in[8][c0 + tid]; bil[tid] = p.in[10][c0 + tid];
        const float lm = p.in[11][c0 + tid]; const float ls = lm >= 0.f ? -log1pf(expf(-lm)) : lm - log1pf(expf(lm)); cl[tid] = 8.0f * ls; carry[tid] = 0.f; }
    __syncthreads();
    const bf16_t* P1 = p.P1;
    const size_t tb = (size_t)b * S_;
    for (int tile = 0; tile < 16; ++tile) {
        const int s0 = tile * 128;
        {
            const int tok = tid >> 2, cq = (tid & 3) * 16;
            float acc[16];
#pragma unroll
            for (int j = 0; j < 16; ++j) acc[j] = cb[cq + j];
#pragma unroll
            for (int tap = 0; tap < 4; ++tap) {
                const int s = s0 + tok + tap - 3;
                if (s >= 0) {
                    const u32x4 v0 = *(const u32x4*)(P1 + (tb + s) * 3072 + c0 + cq), v1 = *(const u32x4*)(P1 + (tb + s) * 3072 + c0 + cq + 8);
                    const unsigned w[8] = {v0.x, v0.y, v0.z, v0.w, v1.x, v1.y, v1.z, v1.w};
#pragma unroll
                    for (int j = 0; j < 8; ++j) { acc[2 * j] += cw[tap * 64 + cq + 2 * j] * bf_lo(w[j]); acc[2 * j + 1] += cw[tap * 64 + cq + 2 * j + 1] * bf_hi(w[j]); }
                }
            }
#pragma unroll
            for (int j = 0; j < 4; ++j) *(LAS f32x4*)(xcf + tok * LRU_XSTR + cq + 4 * j) = (f32x4){acc[4 * j], acc[4 * j + 1], acc[4 * j + 2], acc[4 * j + 3]};
        }
        __syncthreads();
        {
            const int tg = wid >> 1, nt = wid & 1;
            f32x16 ar, ai;
#pragma unroll
            for (int i = 0; i < 16; ++i) { ar[i] = 0.f; ai[i] = 0.f; }
#pragma unroll
            for (int ks = 0; ks < 4; ++ks) {
                const LAS float* xr = xcf + (tg * 32 + l31) * LRU_XSTR + 16 * ks + 8 * hh;
                const f32x4 x0 = *(const LAS f32x4*)xr, x1 = *(const LAS f32x4*)(xr + 4);
                const bf16x8 af = pack8(x0[0], x0[1], x0[2], x0[3], x1[0], x1[1], x1[2], x1[3]);
                const bf16x8 bfr = *(const LAS bf16x8*)(wrt + ((nt * 32 + l31) * 72 + 16 * ks + 8 * hh) * 2);
                const bf16x8 bfi = *(const LAS bf16x8*)(wit + ((nt * 32 + l31) * 72 + 16 * ks + 8 * hh) * 2);
                ar = MFMA32(af, bfr, ar); ai = MFMA32(af, bfi, ai);
            }
            const int e = nt * 32 + l31;
            const float be_r = brl[e], be_i = bil[e], cle = cl[e];
#pragma unroll
            for (int i = 0; i < 16; ++i) {
                const int tok = tg * 32 + (i & 3) + 8 * (i >> 2) + 4 * hh;
                const float r = fast_sigmoid(ar[i] + be_r), ig = fast_sigmoid(ai[i] + be_i);
                const float log_a = cle * r;
                const float a = __expf(log_a);
                const float xv = xcf[tok * LRU_XSTR + e];
                const float u = __builtin_amdgcn_sqrtf(one_minus_exp(2.0f * log_a)) * (ig * xv);
                abuf[tok * 64 + e] = a; ubuf[tok * 64 + e] = u;
            }
        }
        __syncthreads();
        {
            const int ch = lane, seg = wid;
            float A = 1.f, B = 0.f;
#pragma unroll
            for (int j = 0; j < 16; ++j) { const int tok = seg * 16 + j; const float a = abuf[tok * 64 + ch], u = ubuf[tok * 64 + ch]; A *= a; B = a * B + u; }
            agg[(seg * 64 + ch) * 2] = A; agg[(seg * 64 + ch) * 2 + 1] = B;
            float gav[16];
#pragma unroll
            for (int j = 0; j < 16; ++j) gav[j] = bf2f(P1[(tb + s0 + seg * 16 + j) * 3072 + 512 + c0 + ch]);
            __syncthreads();
            float h = carry[ch];
            for (int sg = 0; sg < seg; ++sg) h = agg[(sg * 64 + ch) * 2] * h + agg[(sg * 64 + ch) * 2 + 1];
            __syncthreads();
#pragma unroll
            for (int j = 0; j < 16; ++j) {
                const int tok = seg * 16 + j; const float a = abuf[tok * 64 + ch], u = ubuf[tok * 64 + ch];
                h = a * h + u;
                const float g = gav[j]; const float z = 0.7978845608028654f * (g + 0.044715f * g * g * g);
                const float y = h * g * fast_rcp(1.0f + __expf(-2.0f * z));
                p.Yb[(tb + s0 + tok) * 1024 + c0 + ch] = (bf16_t)(cvt_pk_bf16(y, 0.f) & 0xffffu);
            }
            if (seg == 7) carry[ch] = h;
        }
        __syncthreads();
    }
}

typedef short v4i16_t __attribute__((ext_vector_type(4)));
DI bf16x8 tr_frag(LAS unsigned char* tile, int r0, int c0, int fr) {
    LAS unsigned char* a = tile + ((r0 + (fr >> 2)) * 136 + c0 + 4 * (fr & 3)) * 2;
    const v4i16_t lo = __builtin_amdgcn_ds_read_tr16_b64_v4i16((LAS v4i16_t*)a), hi = __builtin_amdgcn_ds_read_tr16_b64_v4i16((LAS v4i16_t*)(a + 4 * 136 * 2));
    return __builtin_shufflevector(lo, hi, 0, 1, 2, 3, 4, 5, 6, 7);
}
#define ML_QSTR 136
#define ML_TSTR 72
DI void mlstm_unit(const MegaParams& p, LAS unsigned char* lds, int b, int hd, const int prb = 0) {
    const int tid = opaque_tid(), wid = __builtin_amdgcn_readfirstlane(tid >> 6), lane = tid & 63, fr = lane & 15, g = lane >> 4;
    LAS unsigned char* Qs = lds;
    LAS unsigned char* Ks = lds + 17408;
    LAS unsigned char* Vs = lds + 34816;
    LAS unsigned char* Ss = lds + 52224;
    LAS float* rsp = (LAS float*)(lds + 61440);
    LAS float* qnp = (LAS float*)(lds + 62464);
    LAS float* ssp = (LAS float*)(lds + 64512);
    LAS float* nvec = (LAS float*)(lds + 66560);
    const bf16_t* P1 = p.P1;
    const size_t tb = (size_t)b * S_;
    const float mbi = p.in[12][hd], mbf = p.in[13][hd];
    const int qrow = tid >> 3, qseg = tid & 7;
    const bf16_t* qg = P1 + (tb + qrow) * 3072 + 1024 + hd * 128 + qseg * 8;
    const bf16_t* kg = P1 + (tb + qrow) * 3072 + 1536 + hd * 128 + qseg * 8;
    const bf16_t* vgp = P1 + (tb + qrow) * 3072 + 2048 + hd * 128 + qseg * 8;
    const int qlds = (qrow * ML_QSTR + qseg * 8) * 2;
    LAS float* Tu = (LAS float*)(lds + 67072);
    LAS float* TM = Tu + 2048;
    LAS float* Twi = TM + 2048;
    LAS float* Tfl = Twi + 2048;
    LAS float* Tws = Tfl + 2048;
    LAS float* Tsc = Tws + 2048;
    __syncthreads();
    if (tid < 128) nvec[tid] = 0.f;
#pragma unroll
    for (int q = 0; q < 4; ++q) {
        const int c = 4 * wid + q;
        const float ipre = p.ipfp[(tb + c * 64 + lane) * 8 + hd] + mbi, fpre = p.ipfp[(tb + c * 64 + lane) * 8 + 4 + hd] + mbf;
        const float e = __expf(-fabsf(fpre));
        const float lf = fminf(fpre, 0.f) - __logf(1.0f + e);
        const float bl = wave_scan_add(lf, lane);
        const float ul = ipre - bl;
        const float pm = wave_scan_max(ul, lane);
        Tu[c * 64 + lane] = ul; TM[c * 64 + lane] = pm; Tfl[c * 64 + lane] = bl;
    }
    __syncthreads();
    if (tid == 0) { float mc = 0.f; for (int c = 0; c < 32; ++c) { Tsc[c] = mc; const float M63 = fmaxf(mc, TM[c * 64 + 63]); Tsc[32 + c] = __expf(mc - M63); mc = Tfl[c * 64 + 63] + M63; } }
    __syncthreads();
#pragma unroll
    for (int q = 0; q < 4; ++q) {
        const int c = 4 * wid + q;
        const float mc = Tsc[c];
        const float Ml = fmaxf(mc, TM[c * 64 + lane]), M63 = fmaxf(mc, TM[c * 64 + 63]);
        __builtin_amdgcn_s_waitcnt(0xC07F);
        const float bl = Tfl[c * 64 + lane], ul = Tu[c * 64 + lane];
        const float wi = __expf(mc - Ml), fl = __expf(-bl - Ml), ws = __expf(ul - M63);
        TM[c * 64 + lane] = Ml; Twi[c * 64 + lane] = wi; Tfl[c * 64 + lane] = fl; Tws[c * 64 + lane] = ws;
    }
    f32x4 Cst[8];
#pragma unroll
    for (int dt = 0; dt < 8; ++dt) Cst[dt] = (f32x4){0.f, 0.f, 0.f, 0.f};
    u32x4 rq0, rq1, rk0, rk1, rv0, rv1;
    rq0 = *(const u32x4*)qg; rq1 = *(const u32x4*)(qg + 64); rk0 = *(const u32x4*)kg; rk1 = *(const u32x4*)(kg + 64); rv0 = *(const u32x4*)vgp; rv1 = *(const u32x4*)(vgp + 64);
    const float gn0 = p.in[14][hd * 128 + 16 * wid + 4 * g], gn1 = p.in[14][hd * 128 + 16 * wid + 4 * g + 1], gn2 = p.in[14][hd * 128 + 16 * wid + 4 * g + 2], gn3 = p.in[14][hd * 128 + 16 * wid + 4 * g + 3];
    __syncthreads();
    for (int c = 0; c < 32; ++c) {
        const size_t t0 = tb + (size_t)c * 64;
        *(LAS u32x4*)(Qs + qlds) = rq0; *(LAS u32x4*)(Qs + qlds + 128) = rq1; *(LAS u32x4*)(Ks + qlds) = rk0; *(LAS u32x4*)(Ks + qlds + 128) = rk1;
        *(LAS u32x4*)(Vs + qlds) = rv0; *(LAS u32x4*)(Vs + qlds + 128) = rv1;
        u32x2 og[4];
#pragma unroll
        for (int lt = 0; lt < 4; ++lt) og[lt] = *(const u32x2*)(P1 + (t0 + 16 * lt + fr) * 3072 + 2560 + hd * 128 + 16 * wid + 4 * g);
        if (c + 1 < 32) {
            const size_t adv = (size_t)(c + 1) * 64;
            rq0 = *(const u32x4*)(qg + adv * 3072); rq1 = *(const u32x4*)(qg + adv * 3072 + 64); rk0 = *(const u32x4*)(kg + adv * 3072); rk1 = *(const u32x4*)(kg + adv * 3072 + 64);
            rv0 = *(const u32x4*)(vgp + adv * 3072); rv1 = *(const u32x4*)(vgp + adv * 3072 + 64);
        }
        const LAS float* tu = Tu + c * 64; const LAS float* tM = TM + c * 64; const LAS float* twi = Twi + c * 64; const LAS float* tws = Tws + c * 64;
        const float decay = Tsc[32 + c];
        __syncthreads();
        if (!(prb & 4)) {
            const int lt = wid >> 1;
            const float Mcol = tM[16 * lt + fr];
#pragma unroll
            for (int q = 0; q < 2; ++q) {
                const int st = 2 * (wid & 1) + q;
                f32x4 acc = (f32x4){0.f, 0.f, 0.f, 0.f};
                float rs = 0.f;
                u32x2 w2 = (u32x2){0u, 0u};
                if (st <= lt) {
#pragma unroll
                    for (int kk = 0; kk < 4; ++kk) {
                        const bf16x8 af = *(const LAS bf16x8*)(Ks + ((16 * st + fr) * ML_QSTR + 32 * kk + 8 * g) * 2);
                        const bf16x8 bq = *(const LAS bf16x8*)(Qs + ((16 * lt + fr) * ML_QSTR + 32 * kk + 8 * g) * 2);
                        acc = MFMA16(af, bq, acc);
                    }
                    float v[4];
                    const f32x4 us4 = *(const LAS f32x4*)(tu + 16 * st + 4 * g);
#pragma unroll
                    for (int r = 0; r < 4; ++r) { const int s = 16 * st + 4 * g + r, l = 16 * lt + fr;
                        v[r] = (s <= l) ? acc[r] * __expf(us4[r] - Mcol) : 0.f; rs += v[r]; }
                    w2.x = cvt_pk_bf16(v[0], v[1]); w2.y = cvt_pk_bf16(v[2], v[3]);
                }
                *(LAS u32x2*)(Ss + ((16 * lt + fr) * ML_TSTR + 16 * st + 4 * g) * 2) = w2;
                rs += __shfl_xor(rs, 16); rs += __shfl_xor(rs, 32);
                if (g == 0) rsp[st * 64 + 16 * lt + fr] = rs;
            }
        }
        {
            const LAS unsigned char* qr = Qs + (lane * ML_QSTR + 16 * wid) * 2;
            const u32x4 q0 = *(const LAS u32x4*)qr, q1 = *(const LAS u32x4*)(qr + 16);
            const unsigned w[8] = {q0.x, q0.y, q0.z, q0.w, q1.x, q1.y, q1.z, q1.w};
            float a = 0.f;
#pragma unroll
            for (int j = 0; j < 8; ++j) a += bf_lo(w[j]) * nvec[16 * wid + 2 * j] + bf_hi(w[j]) * nvec[16 * wid + 2 * j + 1];
            qnp[wid * 64 + lane] = a;
        }
        __syncthreads();
        f32x4 H[4];
        {
            bf16x8 cf[4];
#pragma unroll
            for (int kk = 0; kk < 4; ++kk) cf[kk] = pack8(Cst[2 * kk][0], Cst[2 * kk][1], Cst[2 * kk][2], Cst[2 * kk][3], Cst[2 * kk + 1][0], Cst[2 * kk + 1][1], Cst[2 * kk + 1][2], Cst[2 * kk + 1][3]);
            bf16x8 vfr[2];
#pragma unroll
            for (int kk = 0; kk < 2; ++kk) vfr[kk] = tr_frag(Vs, 32 * kk + 8 * g, 16 * wid, fr);
            float qn = 0.f, rsum = 0.f;
#pragma unroll
            for (int q = 0; q < 8; ++q) qn += qnp[q * 64 + lane];
#pragma unroll
            for (int q = 0; q < 4; ++q) rsum += rsp[q * 64 + lane];
            const float den = twi[lane] * qn + rsum;
            const float hdiv = fast_rcp(fmaxf(fabsf(den), Tfl[c * 64 + lane]));
#pragma unroll
            for (int lt = 0; lt < 4; ++lt) {
                f32x4 acc = (f32x4){0.f, 0.f, 0.f, 0.f};
#pragma unroll
                for (int kk = 0; kk < 4; ++kk) {
                    const LAS unsigned char* qp = Qs + ((16 * lt + fr) * ML_QSTR + 32 * kk + 4 * g) * 2;
                    const s16x4 lo = *(const LAS s16x4*)qp, hi = *(const LAS s16x4*)(qp + 32);
                    const bf16x8 bq = __builtin_shufflevector(lo, hi, 0, 1, 2, 3, 4, 5, 6, 7);
                    acc = MFMA16(cf[kk], bq, acc);
                }
                const float wl = twi[16 * lt + fr];
                acc = acc * wl;
#pragma unroll
                for (int kk = 0; kk < 2; ++kk) {
                    const bf16x8 bs = *(const LAS bf16x8*)(Ss + ((16 * lt + fr) * ML_TSTR + 32 * kk + 8 * g) * 2);
                    acc = MFMA16(vfr[kk], bs, acc);
                }
                const float hd_ = __shfl(hdiv, 16 * lt + fr);
                acc = acc * hd_;
                H[lt] = acc;
                float sq = acc[0] * acc[0] + acc[1] * acc[1] + acc[2] * acc[2] + acc[3] * acc[3];
                sq += __shfl_xor(sq, 16); sq += __shfl_xor(sq, 32);
                if (g == 0) ssp[wid * 64 + 16 * lt + fr] = sq;
            }
            bf16x8 vw[2];
#pragma unroll
            for (int kk = 0; kk < 2; ++kk) {
                const f32x4 w0 = *(const LAS f32x4*)(tws + 32 * kk + 8 * g), w1 = *(const LAS f32x4*)(tws + 32 * kk + 8 * g + 4);
                const u32x4 vv = __builtin_bit_cast(u32x4, vfr[kk]);
                vw[kk] = pack8(bf_lo(vv.x) * w0[0], bf_hi(vv.x) * w0[1], bf_lo(vv.y) * w0[2], bf_hi(vv.y) * w0[3], bf_lo(vv.z) * w1[0], bf_hi(vv.z) * w1[1], bf_lo(vv.w) * w1[2], bf_hi(vv.w) * w1[3]);
            }
            const f32x4 wa0 = *(const LAS f32x4*)(tws + 8 * g), wa1 = *(const LAS f32x4*)(tws + 8 * g + 4), wb0 = *(const LAS f32x4*)(tws + 32 + 8 * g), wb1 = *(const LAS f32x4*)(tws + 32 + 8 * g + 4);
            float npart = 0.f;
            if (!(prb & 2))
#pragma unroll
            for (int dt = 0; dt < 8; ++dt) {
                f32x4 acc = Cst[dt] * decay;
                const bf16x8 ak0 = tr_frag(Ks, 8 * g, 16 * dt, fr), ak1 = tr_frag(Ks, 32 + 8 * g, 16 * dt, fr);
                acc = MFMA16(ak0, vw[0], acc); acc = MFMA16(ak1, vw[1], acc);
                Cst[dt] = acc;
                if (dt == wid) {
                    const u32x4 x0 = __builtin_bit_cast(u32x4, ak0), x1 = __builtin_bit_cast(u32x4, ak1);
                    npart = bf_lo(x0.x) * wa0[0] + bf_hi(x0.x) * wa0[1] + bf_lo(x0.y) * wa0[2] + bf_hi(x0.y) * wa0[3] + bf_lo(x0.z) * wa1[0] + bf_hi(x0.z) * wa1[1] + bf_lo(x0.w) * wa1[2] + bf_hi(x0.w) * wa1[3]
                          + bf_lo(x1.x) * wb0[0] + bf_hi(x1.x) * wb0[1] + bf_lo(x1.y) * wb0[2] + bf_hi(x1.y) * wb0[3] + bf_lo(x1.z) * wb1[0] + bf_hi(x1.z) * wb1[1] + bf_lo(x1.w) * wb1[2] + bf_hi(x1.w) * wb1[3];
                }
            }
            npart += __shfl_xor(npart, 16); npart += __shfl_xor(npart, 32);
            if (g == 0) nvec[16 * wid + fr] = decay * nvec[16 * wid + fr] + npart;
        }
        __syncthreads();
        if (prb & 1) { asm volatile("" :: "v"(H[0]), "v"(H[1]), "v"(H[2]), "v"(H[3]), "v"(og[0]), "v"(og[1]), "v"(og[2]), "v"(og[3])); }
        else {
            float ssq = 0.f;
#pragma unroll
            for (int q = 0; q < 8; ++q) ssq += ssp[q * 64 + lane];
            const float rstd = rsqrtf(ssq * (1.0f / 128.0f) + EPS_);
#pragma unroll
            for (int lt = 0; lt < 4; ++lt) {
                const float rl = __shfl(rstd, 16 * lt + fr);
                const float o0 = bf_lo(og[lt].x), o1 = bf_hi(og[lt].x), o2 = bf_lo(og[lt].y), o3 = bf_hi(og[lt].y);
                u32x2 w; w.x = cvt_pk_bf16(H[lt][0] * rl * gn0 * fast_sigmoid(o0), H[lt][1] * rl * gn1 * fast_sigmoid(o1)); w.y = cvt_pk_bf16(H[lt][2] * rl * gn2 * fast_sigmoid(o2), H[lt][3] * rl * gn3 * fast_sigmoid(o3));
                *(u32x2*)(p.Yb + (t0 + 16 * lt + fr) * 1024 + 512 + hd * 128 + 16 * wid + 4 * g) = w;
            }
        }
    }
}

DI void phase_mixer(const MegaParams& p, LAS unsigned char* lds, LAS unsigned char* misc, int only = 0) {
    for (int u = blockIdx.x; u < 192; u += gridDim.x) {
        if (u < 64) { if ((only & 3) != 2) mlstm_unit(p, lds, u >> 2, u & 3, only >> 4); }
        else { if ((only & 3) != 1) lru_unit(p, lds, (u - 64) >> 3, (u - 64) & 7); }
    }
    if (p.prep_mask & 64u) {
        LAS int* qslot = (LAS int*)(misc + 2048);
        __syncthreads();
        for (;;) {
            if (threadIdx.x == 0) *qslot = (int)atomicAdd(p.ctl + CTL_QUEUE, 1u);
            __syncthreads();
            const int g = *qslot;
            __syncthreads();
            if (g >= MOE_PREP_GROUPS + AUX_PREP_GROUPS) break;
            if (g < AUX_PREP_GROUPS) aux_prep_group(p, (LAS float*)lds, g); else moe_prep_group(p, (LAS float*)lds, g - AUX_PREP_GROUPS);
        }
    }
}
#ifndef HAVE_MIXER
#define HAVE_MIXER 1
#endif
#ifndef HAVE_ATTN
#define HAVE_ATTN 1
#endif
__global__ void __launch_bounds__(512, 2) mega(MegaParams p) {
    extern __shared__ __attribute__((aligned(16))) unsigned char lds_raw[];
    LAS unsigned char* lds = (LAS unsigned char*)lds_raw;
    LAS unsigned char* misc = lds + MISC_OFF;
    const int tid = threadIdx.x, G = gridDim.x;
    const int vcu = (G % 8 == 0) ? ((int)blockIdx.x % 8) * (G / 8) + (int)blockIdx.x / 8 : (int)blockIdx.x;
    (void)vcu;
    if (tid < 4) ((LAS unsigned*)(misc + 1024))[tid] = 0u;
    __syncthreads();
    XcdBarrier bar = xcd_barrier_post(p.ctl, (volatile LAS unsigned*)(misc + 1024));
    const int lo = p.ph_lo, hi = p.ph_hi;
#define IN(k) (lo <= (k) && (k) < hi)
#define SEAM(k) do { if (IN(k) && IN((k) + 1)) xcd_barrier(bar); } while (0)

    if (IN(0)) { asm volatile("; PHASE_MARK 0"); } if (IN(0)) phase_prep(p, lds);
    SEAM(0);
    if (IN(1)) { asm volatile("; PHASE_MARK 1"); } if (IN(1)) {
        { gm::PlainSched S{p.xb, p.WinN, T_ / 256, 3072 / 256, 1024, G, (int)blockIdx.x, opaque_tid() * 16}; gm::EpiPlainBf16 E{p.P1, 3072}; gm::gemm_phase(lds, 1024, S, E); }
    }
    SEAM(1);
    if (IN(2)) { asm volatile("; PHASE_MARK 2"); } if (IN(2)) phase_mixer(p, lds, misc);
    SEAM(2);
    if (IN(3)) { asm volatile("; PHASE_MARK 3"); } if (IN(3)) { gm::PlainSched S{p.Yb, p.Wout, T_ / 256, 4, 1024, G, (int)blockIdx.x, opaque_tid() * 16}; gm::EpiPlainBf16 E{p.dA, D_}; gm::gemm_phase(lds, 1024, S, E); }
    SEAM(3);
    if (IN(4)) { asm volatile("; PHASE_MARK 4"); } if (IN(4)) phase_router(p, lds, p.dA, p.Wr, p.in[23], p.in[25], p.ctl + CTL_CNT(0));
    SEAM(4);
    if (IN(5)) { asm volatile("; PHASE_MARK 5"); } if (IN(5)) { MoeTables tb = moe_tables(misc, p.ctl + CTL_CNT(0)); MoeUpSched S{p.xb, p.Wup, p.lists, tb, G, (int)blockIdx.x, opaque_tid() * 16}; EpiSwiglu E{p.act, p.slot_rs, tb.tp}; gm::gemm_phase(lds, 1024, S, E); }
    SEAM(5);
    if (IN(6)) { asm volatile("; PHASE_MARK 6"); } if (IN(6)) { MoeTables tb = moe_tables(misc, p.ctl + CTL_CNT(0)); MoeDownSched S{p.act, p.Wdn, tb, G, (int)blockIdx.x, opaque_tid() * 16}; EpiMoeDown E{p.ybuf, p.lists, p.slot_gw, tb.tp}; gm::gemm_phase(lds, 512, S, E); }
    SEAM(6);
    if (IN(7)) { asm volatile("; PHASE_MARK 7"); } if (IN(7)) phase_combine<0>(p, nullptr, nullptr);
    SEAM(7);
    if (IN(8)) { asm volatile("; PHASE_MARK 8"); } if (IN(8)) {
        { gm::PlainSched S{p.xb, p.Wqkv, T_ / 256, 3072 / 256, 1024, G, (int)blockIdx.x, opaque_tid() * 16}; gm::EpiQK E{p.P1, p.ctl + CTL_KMAX}; gm::gemm_phase(lds, 1024, S, E); }
    }
    SEAM(8);
    if (IN(9)) { asm volatile("; PHASE_MARK 9"); } if (IN(9)) phase_attn(p, lds, misc);
    SEAM(9);
    if (IN(10)) { asm volatile("; PHASE_MARK 10"); } if (IN(10)) { gm::PlainSched S{p.Yb, p.Wo, T_ / 256, 4, 1024, G, (int)blockIdx.x, opaque_tid() * 16}; gm::EpiPlainBf16 E{p.dA, D_}; gm::gemm_phase(lds, 1024, S, E); }
    SEAM(10);
    if (IN(11)) { asm volatile("; PHASE_MARK 11"); } if (IN(11)) phase_router(p, lds, p.dA, p.Wr + 48 * 1024, p.in[23] + 4, p.in[25] + 32, p.ctl + CTL_CNT(1));
    SEAM(11);
    if (IN(12)) { asm volatile("; PHASE_MARK 12"); } if (IN(12)) { MoeTables tb = moe_tables(misc, p.ctl + CTL_CNT(1)); MoeUpSched S{p.xb, p.Wup + (size_t)32 * 1024 * 1024, p.lists, tb, G, (int)blockIdx.x, opaque_tid() * 16}; EpiSwiglu E{p.act, p.slot_rs, tb.tp}; gm::gemm_phase(lds, 1024, S, E); }
    SEAM(12);
    if (IN(13)) { asm volatile("; PHASE_MARK 13"); } if (IN(13)) { MoeTables tb = moe_tables(misc, p.ctl + CTL_CNT(1)); MoeDownSched S{p.act, p.Wdn + (size_t)32 * 1024 * 512, tb, G, (int)blockIdx.x, opaque_tid() * 16}; EpiMoeDown E{p.ybuf, p.lists, p.slot_gw, tb.tp}; gm::gemm_phase(lds, 512, S, E); }
    SEAM(13);
    if (IN(14)) { asm volatile("; PHASE_MARK 14"); } if (IN(14)) phase_combine<1>(p, p.out, p.in[28]);
#undef IN
#undef SEAM
}
static char* carve_mega(char* ws, MegaParams& p) {
    char* q = ws; auto tk = [&](size_t b) { char* r = q; q += (b + 255) & ~(size_t)255; return r; };
    p.ctl = (unsigned*)tk(16384);
    p.WinN = (bf16_t*)tk((size_t)3072 * 1024 * 2); p.WinT = nullptr; p.Wout = (bf16_t*)tk((size_t)1024 * 1024 * 2);
    p.Wqkv = (bf16_t*)tk((size_t)3072 * 1024 * 2); p.Wo = (bf16_t*)tk((size_t)1024 * 1024 * 2);
    p.Wup = (bf16_t*)tk((size_t)64 * 1024 * 1024 * 2); p.Wdn = (bf16_t*)tk((size_t)64 * 1024 * 512 * 2); p.Wr = (bf16_t*)tk((size_t)2 * 48 * 1024 * 2);
    p.xb = (bf16_t*)tk((size_t)T_ * 1024 * 2); p.rstd = (float*)tk((size_t)T_ * 4); p.ipfp = (float*)tk((size_t)T_ * 8 * 4);
    char* rp = tk((size_t)T_ * 3072 * 2);
    p.P1 = (bf16_t*)rp; p.PT = nullptr;
    p.act = (bf16_t*)rp; p.ybuf = (bf16_t*)(rp + (((size_t)(2 * T_ + 8192) * 512 * 2 + 255) & ~(size_t)255));
    p.Yb = (bf16_t*)tk((size_t)T_ * 1024 * 2);
    p.lists = (int*)tk((size_t)32 * T_ * 4); p.slot_rs = (float*)tk((size_t)32 * T_ * 4); p.slot_gw = (float*)tk((size_t)32 * T_ * 4);
    p.dA = (bf16_t*)tk((size_t)T_ * D_ * 2); p.hB = (bf16_t*)tk((size_t)T_ * D_ * 2);
    return q;
}
static int mega_grid() {
    static int grid = 0;
    if (grid == 0) {
        int dev = 0, cus = 0, per_cu = 0; (void)hipGetDevice(&dev); (void)hipDeviceGetAttribute(&cus, hipDeviceAttributeMultiprocessorCount, dev);
        (void)hipFuncSetAttribute((const void*)mega, hipFuncAttributeMaxDynamicSharedMemorySize, MEGA_LDS_BYTES);
        (void)hipOccupancyMaxActiveBlocksPerMultiprocessor(&per_cu, (const void*)mega, 512, MEGA_LDS_BYTES);
        (void)hipGetLastError();
        grid = cus > 0 ? cus : 256;
    }
    return grid;
}
extern "C" void kernel_launch(void* const* d_in, const int* in_sizes, int n_in, void* d_out, int out_size, void* d_ws, size_t ws_size, hipStream_t stream) {
    MegaParams p{};
    for (int i = 0; i < 29; ++i) p.in[i] = (const float*)d_in[i];
    p.out = (float*)d_out;
    (void)carve_mega((char*)d_ws, p);
    p.prep_mask = 0x1c3u;     p.pad = -1; p.ph_lo = 0; p.ph_hi = 15;
    (void)hipMemsetAsync(p.ctl, 0, 16384, stream);
    hipLaunchKernelGGL(mega, dim3(mega_grid()), dim3(512), MEGA_LDS_BYTES, stream, p);
}
```

```cpp
#include <hip/hip_runtime.h>
#include <math.h>
#include <stdint.h>

#define T_   32768
#define D_   1024
#define S_   2048
#define NB_  16
#define PROJ_N 3080
#define EPS_ 1e-6f

typedef unsigned short bf16_t;
typedef short bf16x8 __attribute__((ext_vector_type(8)));
typedef short s16x4 __attribute__((ext_vector_type(4)));
typedef float f32x4 __attribute__((ext_vector_type(4)));
typedef float f32x2 __attribute__((ext_vector_type(2)));
typedef float f32x16 __attribute__((ext_vector_type(16)));
typedef unsigned u32x4 __attribute__((ext_vector_type(4)));
typedef unsigned u32x2 __attribute__((ext_vector_type(2)));
#define LAS __attribute__((address_space(3)))
#define DI __device__ __forceinline__
DI int opaque_tid() { int t = (int)threadIdx.x; asm volatile("" : "+v"(t)); return t; }
DI float xor16_sum(float x) { const auto r = __builtin_amdgcn_permlane16_swap(__float_as_uint(x), __float_as_uint(x), false, false); return __uint_as_float(r[0]) + __uint_as_float(r[1]); }
DI float xor32_sum(float x) { const auto r = __builtin_amdgcn_permlane32_swap(__float_as_uint(x), __float_as_uint(x), false, false); return __uint_as_float(r[0]) + __uint_as_float(r[1]); }
DI float xor32_max(float x) { const auto r = __builtin_amdgcn_permlane32_swap(__float_as_uint(x), __float_as_uint(x), false, false); return fmaxf(__uint_as_float(r[0]), __uint_as_float(r[1])); }
DI void st_wt16(void* q, const u32x4& v) { asm volatile("global_store_dwordx4 %0, %1, off sc1\n\ts_nop 3" :: "v"(q), "v"(v) : "memory"); }
DI void poll_acquire(unsigned* w, unsigned need) {
    unsigned tries = 1u << 20, got;
    asm volatile("1:\n\tglobal_load_dword %0, %2, off sc1\n\ts_waitcnt vmcnt(0)\n\tv_cmp_gt_u32 vcc, %3, %0\n\ts_nop 4\n\ts_cbranch_vccz 2f\n\ts_sleep 2\n\tv_subrev_u32 %1, 1, %1\n\tv_cmp_ne_u32 vcc, 0, %1\n\ts_nop 4\n\ts_cbranch_vccnz 1b\n2:\n\tbuffer_inv sc1\n\ts_waitcnt vmcnt(0)" : "=&v"(got), "+v"(tries) : "v"(w), "v"(need) : "vcc", "memory");
}
DI int lane_id() { int l = (int)__builtin_amdgcn_mbcnt_hi(~0u, __builtin_amdgcn_mbcnt_lo(~0u, 0u)); asm volatile("" : "+v"(l)); return l; }

typedef __bf16 nbf16x2 __attribute__((ext_vector_type(2)));
DI unsigned cvt_pk_bf16(float lo, float hi) { const f32x2 v = {lo, hi}; return __builtin_bit_cast(unsigned, __builtin_convertvector(v, nbf16x2)); }
DI float wave_sum_uniform(float v) {
    int t = __builtin_bit_cast(int, v);
    v += __builtin_bit_cast(float, __builtin_amdgcn_update_dpp(0, t, 0xB1, 0xF, 0xF, true)); t = __builtin_bit_cast(int, v);
    v += __builtin_bit_cast(float, __builtin_amdgcn_update_dpp(0, t, 0x4E, 0xF, 0xF, true)); t = __builtin_bit_cast(int, v);
    v += __builtin_bit_cast(float, __builtin_amdgcn_update_dpp(0, t, 0x124, 0xF, 0xF, true)); t = __builtin_bit_cast(int, v);
    v += __builtin_bit_cast(float, __builtin_amdgcn_update_dpp(0, t, 0x128, 0xF, 0xF, true)); t = __builtin_bit_cast(int, v);
    return (__builtin_bit_cast(float, __builtin_amdgcn_readlane(t, 0)) + __builtin_bit_cast(float, __builtin_amdgcn_readlane(t, 16)))
         + (__builtin_bit_cast(float, __builtin_amdgcn_readlane(t, 32)) + __builtin_bit_cast(float, __builtin_amdgcn_readlane(t, 48)));
}
DI float bf_lo(unsigned w) { return __uint_as_float(w << 16); }
DI float bf_hi(unsigned w) { return __uint_as_float(w & 0xffff0000u); }
DI float bf2f(bf16_t b) { return __uint_as_float(((unsigned)b) << 16); }

#define XB_TMO      128
#define XB_XCNT(j)  (256  + 64 * (j))
#define XB_XSUB(j)  (1280 + 64 * (j))
#define XB_XGEN(j)  (2304 + 64 * (j))
#define XB_TOP      3328
#define XB_TOPGEN   3392
#define XCD_BAR_WORDS 3456
#define XB_SPIN_CAP (1u << 18)
DI unsigned xb_ld(unsigned* p)              { return __hip_atomic_load(p, __ATOMIC_RELAXED, __HIP_MEMORY_SCOPE_AGENT); }
DI unsigned xb_add(unsigned* p, unsigned v) { return __hip_atomic_fetch_add(p, v, __ATOMIC_RELAXED, __HIP_MEMORY_SCOPE_AGENT); }
DI unsigned xb_xcc_id() { return (unsigned)__builtin_amdgcn_s_getreg((3 << 11) | 20) & 0xFu; }
#define XB_SPIN(cond, bar) do { unsigned _sp = 0; while (cond) { __builtin_amdgcn_s_sleep(1); \
    if ((++_sp & 255u) == 0u) { if (xb_ld(&(bar)[XB_TMO])) break; if (_sp > XB_SPIN_CAP) { atomicAdd(&(bar)[XB_TMO], 1u); break; } } } } while (0)
struct XcdBarrier { unsigned* bar; unsigned x; volatile LAS unsigned* st; };
DI XcdBarrier xcd_barrier_post(unsigned* bar, volatile LAS unsigned* st) {
    XcdBarrier b; b.bar = bar; b.x = xb_xcc_id(); b.st = st;
    if (threadIdx.x == 0) (void)xb_add(&bar[XB_XCNT(b.x)], 1u);
    return b;
}
DI void xcd_barrier_complete(unsigned* bar, unsigned x, unsigned& nloc, unsigned& nx) {
    const unsigned G = gridDim.x * gridDim.y * gridDim.z;
    unsigned sum, cnt, mine, sp = 0u;
    for (;;) {
        sum = 0u; cnt = 0u; mine = 0u;
#pragma unroll
        for (unsigned j = 0; j < 16; ++j) { const unsigned c = xb_ld(&bar[XB_XCNT(j)]); sum += c; cnt += (c > 0u) ? 1u : 0u; mine = (j == x) ? c : mine; }
        if (sum == G) break;
        __builtin_amdgcn_s_sleep(1);
        if ((++sp & 255u) == 0u) { if (xb_ld(&bar[XB_TMO])) break; if (sp > XB_SPIN_CAP) { atomicAdd(&bar[XB_TMO], 1u); break; } }
    }
    nloc = mine > 0u ? mine : 1u; nx = cnt > 0u ? cnt : 1u;
}
DI void xcd_barrier(const XcdBarrier& b) {
    asm volatile("s_waitcnt vmcnt(0)" ::: "memory");
    __syncthreads();
    if (threadIdx.x == 0) {
        unsigned* bar = b.bar;
        __builtin_amdgcn_s_waitcnt(0);
        unsigned nloc = b.st[0], nx = b.st[1];
        if (nloc == 0u) { xcd_barrier_complete(bar, b.x, nloc, nx); b.st[0] = nloc; b.st[1] = nx; }
        const unsigned old = xb_add(&bar[XB_XSUB(b.x)], 1u);
        const unsigned gen = old / nloc;
        if (old + 1u == (gen + 1u) * nloc) {
            __builtin_amdgcn_fence(__ATOMIC_RELEASE, "agent");
            asm volatile("s_waitcnt vmcnt(0)" ::: "memory");
            const unsigned og = xb_add(&bar[XB_TOP], 1u);
            const unsigned tg = og / nx;
            if (og + 1u == (tg + 1u) * nx) xb_add(&bar[XB_TOPGEN], 1u);
            else XB_SPIN(xb_ld(&bar[XB_TOPGEN]) == tg, bar);
            __builtin_amdgcn_fence(__ATOMIC_ACQUIRE, "agent");
            xb_add(&bar[XB_XGEN(b.x)], 1u);
            asm volatile("s_waitcnt vmcnt(0)" ::: "memory");
        } else {
            XB_SPIN(xb_ld(&bar[XB_XGEN(b.x)]) == gen, bar);
            __builtin_amdgcn_fence(__ATOMIC_ACQUIRE, "agent");
            asm volatile("s_waitcnt vmcnt(0)" ::: "memory");
        }
    }
    __syncthreads();
}

#ifndef GM_SKEW
#define GM_SKEW 0
#endif
namespace gm {
constexpr int BM = 256, BK = 64, HALF = 128, HTB = HALF * BK * 2, STAGE_BYTES = 8 * HTB, NXCD = 8, WGM = 8;
DI int lds_byte(int r, int c) { const int st = (r >> 4) * 2 + (c >> 5), rr = r & 15, cc = c & 31, ob = rr * 64 + cc * 2; return st * 1024 + (ob ^ (((ob >> 9) & 1) << 5)); }
DI void stage_rc(int b, int& R, int& C) { const int st = b / 1024, sb = b % 1024, swz = sb ^ (((sb >> 9) & 1) << 5); R = (st >> 1) * 16 + swz / 64; C = (st & 1) * 32 + (swz % 64) / 2; }
DI int rho16(int i) { return (i >> 1) + 8 * (i & 1); }
DI int perm32(int rho) { const int n = rho >> 4, i = rho & 15; return 8 * (i >> 2) + 4 * n + (i & 3); }

struct Unit {
    const char* aB;
    const char* bB;
    int pm, pn, e, cnt;
    int mt;
};
#define GM_NO_SCHED_WAIT static constexpr bool WAITS = false; DI void a_ready(int, int) const {}
#define GM_NO_EPI_PUB static constexpr bool PUBLISH = false; DI void publish(int, int) const {}
#define GM_NO_SCHED_SIDE DI void side_issue(LAS unsigned char*, const gm::Unit&, int) const {} DI void fill_va(LAS unsigned char*, const gm::Unit&, unsigned (&)[2][2], int, int) const {}
#define GM_NO_EPI_SIDE DI void side_issue(LAS unsigned char*, const gm::Unit&, int) const {}
DI bool static_tile(int i, int G, int c, int nM, int nN, int& pm, int& pn) {
    const int nwg = nM * nN; const long L = (long)i * G + c; if (L >= nwg) return false;
    int wgid = (int)L; { const int q = nwg / NXCD, r = nwg % NXCD, xcd = wgid % NXCD, off = wgid / NXCD; wgid = (xcd < r ? xcd * (q + 1) : r * (q + 1) + (xcd - r) * q) + off; }
    const int nig = WGM * nN, gid = wgid / nig, fm = gid * WGM, gsz = (nM - fm) < WGM ? (nM - fm) : WGM;
    pm = fm + ((wgid % nig) % gsz); pn = (wgid % nig) / gsz; return true;
}
template <bool W> struct PlainSchedT {
    static constexpr bool WAITS = W;
    DI void a_ready(int pm, int wid) const { if (W) { if (wid == 0) poll_acquire(ready + pm * 16, need); asm volatile("" ::: "memory"); __builtin_amdgcn_s_barrier(); asm volatile("" ::: "memory"); } }
    static constexpr bool GATHER = false;
    const bf16_t* A; const bf16_t* Bt; int nM, nN, K, G, c; int tid16; unsigned* ready; unsigned need;
    DI bool next(int i, Unit& u) const {
        int pm, pn; if (!static_tile(i, G, c, nM, nN, pm, pn)) return false;
        u.aB = (const char*)A + (size_t)pm * 256 * K * 2; u.bB = (const char*)Bt + (size_t)pn * 256 * K * 2; u.pm = pm; u.pn = pn; u.e = 0; u.cnt = 256; u.mt = 0;
        return true;
    }
    DI void va_direct(const Unit&, unsigned (&va)[2][2]) const { int R, C; stage_rc(opaque_tid() * 16, R, C); R = (R & ~15) + rho16(R & 15); const unsigned v = (unsigned)(R * K + C) * 2u; va[0][0] = v; va[0][1] = v; va[1][0] = v; va[1][1] = v; }
    GM_NO_SCHED_SIDE
};
typedef PlainSchedT<false> PlainSched;

template <class Epi, class Sched>
DI void gemm_phase(LAS unsigned char* lds, const int K, const Sched& S, const Epi& E) {
    const int tid = opaque_tid(), wid = __builtin_amdgcn_readfirstlane(tid >> 6), lane = tid & 63, wr = wid >> 2, wc = wid & 3, fr = lane & 15, fq = lane >> 4;
    const int nt = K / BK;
    unsigned voffB[2];
#pragma unroll
    for (int i = 0; i < 2; ++i) { int R, C; stage_rc(tid * 16 + i * 8192, R, C); const int Rb = 64 * (R >> 5) + perm32(R & 31); voffB[i] = (unsigned)(Rb * K + C) * 2u; }
    const size_t kstep = (size_t)(BK * 2);
    const size_t hstepB = (size_t)32 * K * 2;
    const unsigned ldsw = (unsigned)wid * 1024u;
    const int aoff = lds_byte(wr * 64 + fr, fq * 8), boff = lds_byte(wc * 32 + fr, fq * 8);
#define GM_SA(b, h) (((b) * 2 + (h)) * HTB)
#define GM_SB(b, h) ((4 + (b) * 2 + (h)) * HTB)
#define GM_STAGE_B(bufoff, gbase) do { _Pragma("unroll") for (int _i = 0; _i < 2; ++_i) \
        __builtin_amdgcn_global_load_lds((const unsigned*)((const char*)(gbase) + voffB[_i]), (LAS unsigned*)(lds + (bufoff) + ldsw + _i * 8192), 16, 0, 0); } while (0)
#define GM_STAGE_A(bufoff, gbase, h, v0, v1) do { \
        const char* _g0 = (const char*)(gbase) + (Sched::GATHER ? (size_t)0 : (size_t)((h) * 128) * K * 2); const char* _g1 = (const char*)(gbase) + (Sched::GATHER ? (size_t)0 : (size_t)((h) * 128 + 64) * K * 2); \
        __builtin_amdgcn_global_load_lds((const unsigned*)(_g0 + (v0)), (LAS unsigned*)(lds + (bufoff) + ldsw), 16, 0, 0); \
        __builtin_amdgcn_global_load_lds((const unsigned*)(_g1 + (v1)), (LAS unsigned*)(lds + (bufoff) + ldsw + 8192), 16, 0, 0); } while (0)
#define GM_VA(h, p) (Sched::GATHER ? va[h][p] : va[0][0])
#define GM_LDA(dst, b, h) do { _Pragma("unroll") for (int m = 0; m < 4; ++m) _Pragma("unroll") for (int k = 0; k < 2; ++k) dst[m][k] = *(const LAS bf16x8*)(lds + GM_SA(b, h) + aoff + m * 2048 + k * 1024); } while (0)
#define GM_LDB(dst, b, h) do { _Pragma("unroll") for (int n = 0; n < 2; ++n) _Pragma("unroll") for (int k = 0; k < 2; ++k) dst[n][k] = *(const LAS bf16x8*)(lds + GM_SB(b, h) + boff + n * 2048 + k * 1024); } while (0)
#define GM_MMA(ai, bj, At, Bt) do { __builtin_amdgcn_s_setprio(1); _Pragma("unroll") for (int m = 0; m < 4; ++m) _Pragma("unroll") for (int n = 0; n < 2; ++n) _Pragma("unroll") for (int k = 0; k < 2; ++k) \
        acc[ai][bj][m][n] = __builtin_amdgcn_mfma_f32_16x16x32_bf16(Bt[n][k], At[m][k], acc[ai][bj][m][n], 0, 0, 0); __builtin_amdgcn_s_setprio(0); } while (0)
#define GM_WAIT_V(n) asm volatile("s_waitcnt vmcnt(" #n ")" ::: "memory")
#define GM_WAIT_L(n) asm volatile("s_waitcnt lgkmcnt(" #n ")" ::: "memory")
#define GM_BAR __builtin_amdgcn_s_barrier()
#define GM_SCHED __builtin_amdgcn_sched_barrier(0)
    Unit cur, nxt; int ui = 0;
    if (!S.next(0, cur)) return;
    if (Sched::WAITS) S.a_ready(cur.pm, wid);
    unsigned va[2][2]; S.va_direct(cur, va);
    int pub_pm = -1;
    int tfirst = 0; asm volatile("" : "+s"(tfirst));
    LAS unsigned char* side = lds + STAGE_BYTES + 8192;
    { const int grp = ((int)blockIdx.x >> 3) & 3; for (int i = 0; i < grp * GM_SKEW; ++i) __builtin_amdgcn_s_sleep(32); }
    f32x4 acc[2][2][4][2];
#pragma unroll
    for (int a = 0; a < 2; ++a)
#pragma unroll
        for (int b = 0; b < 2; ++b)
#pragma unroll
            for (int m = 0; m < 4; ++m)
#pragma unroll
                for (int n = 0; n < 2; ++n) acc[a][b][m][n] = (f32x4){0.f, 0.f, 0.f, 0.f};
    bf16x8 At[4][2], B0[2][2], B1[2][2];
    GM_STAGE_B(GM_SB(0, 0), cur.bB); GM_STAGE_A(GM_SA(0, 0), cur.aB, 0, GM_VA(0, 0), GM_VA(0, 1)); GM_STAGE_B(GM_SB(0, 1), cur.bB + hstepB); GM_STAGE_A(GM_SA(0, 1), cur.aB, 1, GM_VA(1, 0), GM_VA(1, 1));
    if (wr == 1) GM_BAR;
    GM_WAIT_V(4); GM_BAR;
    GM_STAGE_B(GM_SB(1, 0), cur.bB + kstep); GM_STAGE_A(GM_SA(1, 0), cur.aB + kstep, 0, GM_VA(0, 0), GM_VA(0, 1)); GM_STAGE_B(GM_SB(1, 1), cur.bB + hstepB + kstep);
    GM_WAIT_V(6); GM_BAR;
    for (;;) {
        const bool has_next = S.next(ui + 1, nxt);
        if (!has_next) nxt = cur;
        asm volatile(".p2align 6");
        for (int t = 0; t < nt; t += 2) {
            const bool last = (t == nt - 2);
            const char* a1 = cur.aB + (size_t)(t + 1) * kstep;
            const char* a2 = last ? nxt.aB : cur.aB + (size_t)(t + 2) * kstep; const char* b2 = last ? nxt.bB : cur.bB + (size_t)(t + 2) * kstep;
            const char* a3 = a2 + kstep; const char* b3 = b2 + kstep;
            if (Sched::WAITS && last && has_next) S.a_ready(nxt.pm, wid);
            if (Sched::GATHER && last && has_next) S.fill_va(side, nxt, va, 0, wid * 64 + lane_id());
            GM_LDB(B0, 0, 0); GM_SCHED; GM_LDA(At, 0, 0); GM_STAGE_A(GM_SA(1, 1), a1, 1, GM_VA(1, 0), GM_VA(1, 1));
            GM_WAIT_L(8); GM_BAR; GM_WAIT_L(0); GM_MMA(0, 0, At, B0); GM_BAR; GM_SCHED;
            GM_LDB(B1, 0, 1); GM_STAGE_B(GM_SB(0, 0), b2);
            GM_BAR; GM_WAIT_L(0); GM_MMA(0, 1, At, B1); GM_BAR;
            GM_LDA(At, 0, 1); GM_STAGE_A(GM_SA(0, 0), a2, 0, GM_VA(0, 0), GM_VA(0, 1));
            GM_BAR; GM_WAIT_L(0); GM_MMA(1, 0, At, B0); GM_BAR; GM_SCHED;
            GM_STAGE_B(GM_SB(0, 1), b2 + hstepB);
            GM_WAIT_V(6);
            if (Epi::PUBLISH && t == tfirst && pub_pm >= 0) { E.publish(pub_pm, lane_id()); pub_pm = -1; }
            GM_BAR; GM_MMA(1, 1, At, B1); GM_BAR;
            if (t == tfirst && wid == 0) { const int l2 = lane_id(); E.side_issue(side, cur, l2); if (has_next) S.side_issue(side, nxt, l2); }
            if (Sched::GATHER && last && has_next) S.fill_va(side, nxt, va, 1, wid * 64 + lane_id());
            GM_LDB(B0, 1, 0); GM_SCHED; GM_LDA(At, 1, 0); GM_STAGE_A(GM_SA(0, 1), a2, 1, GM_VA(1, 0), GM_VA(1, 1));
            GM_WAIT_L(8); GM_BAR; GM_WAIT_L(0); GM_MMA(0, 0, At, B0); GM_BAR; GM_SCHED;
            GM_LDB(B1, 1, 1); GM_STAGE_B(GM_SB(1, 0), b3);
            GM_BAR; GM_WAIT_L(0); GM_MMA(0, 1, At, B1); GM_BAR;
            GM_LDA(At, 1, 1); GM_STAGE_A(GM_SA(1, 0), a3, 0, GM_VA(0, 0), GM_VA(0, 1));
            GM_BAR; GM_WAIT_L(0); GM_MMA(1, 0, At, B0); GM_BAR; GM_SCHED;
            GM_STAGE_B(GM_SB(1, 1), b3 + hstepB);
            GM_WAIT_V(6); GM_BAR; GM_MMA(1, 1, At, B1); GM_BAR;
        }
        { const int l2 = lane_id(); E(acc, cur, wr, wc, l2 & 15, l2 >> 4, side); }
        if (Epi::PUBLISH) pub_pm = cur.pm;
        if (!has_next) break;
#pragma unroll
        for (int a = 0; a < 2; ++a)
#pragma unroll
            for (int b = 0; b < 2; ++b)
#pragma unroll
                for (int m = 0; m < 4; ++m)
#pragma unroll
                    for (int n = 0; n < 2; ++n) acc[a][b][m][n] = (f32x4){0.f, 0.f, 0.f, 0.f};
        cur = nxt; ++ui;
    }
    GM_WAIT_V(0);
    if (Epi::PUBLISH && pub_pm >= 0) E.publish(pub_pm, lane_id());
    if (wr == 0) GM_BAR;
    GM_BAR;
#undef GM_SA
#undef GM_SB
#undef GM_STAGE_A
#undef GM_VA
#undef GM_STAGE_B
#undef GM_LDA
#undef GM_LDB
#undef GM_MMA
#undef GM_WAIT_V
#undef GM_WAIT_L
#undef GM_BAR
#undef GM_SCHED
}

DI unsigned dpp_ror8(unsigned x) { return (unsigned)__builtin_amdgcn_update_dpp(0, (int)x, 0xB1, 0xF, 0xF, true); }
DI void xchg_lines(const u32x4& p0, const u32x4& p1, int fr, u32x4& a, u32x4& b) {
    const bool lo = (fr & 1) == 0;
    const u32x4 send = lo ? p1 : p0; u32x4 recv;
    recv.x = dpp_ror8(send.x); recv.y = dpp_ror8(send.y); recv.z = dpp_ror8(send.z); recv.w = dpp_ror8(send.w);
    a = lo ? p0 : recv; b = lo ? recv : p1;
}
DI u32x4 pack_piece(const f32x4& v0, const f32x4& v1) { u32x4 w; w.x = cvt_pk_bf16(v0[0], v0[1]); w.y = cvt_pk_bf16(v0[2], v0[3]); w.z = cvt_pk_bf16(v1[0], v1[1]); w.w = cvt_pk_bf16(v1[2], v1[3]); return w; }
template <bool PUB> struct EpiPlainBf16T {
    static constexpr bool PERM = true; GM_NO_EPI_SIDE
    static constexpr bool PUBLISH = PUB;
    bf16_t* O; int ldc; unsigned* ready;
    DI void publish(int pm, int lane) const { if (PUB && lane == 0) (void)__hip_atomic_fetch_add(ready + pm * 16, 1u, __ATOMIC_RELAXED, __HIP_MEMORY_SCOPE_AGENT); }
    DI void operator()(const f32x4 (&acc)[2][2][4][2], const Unit& u, int wr, int wc, int fr, int fq, LAS unsigned char* side) const {
        bf16_t* base = O + (size_t)(u.pm * BM + wr * 64 + (fr >> 1)) * ldc + u.pn * BM + wc * 64 + 32 * (fr & 1) + 8 * fq;
#pragma unroll
        for (int ai = 0; ai < 2; ++ai)
#pragma unroll
            for (int m = 0; m < 4; ++m) { u32x4 a, b; xchg_lines(pack_piece(acc[ai][0][m][0], acc[ai][0][m][1]), pack_piece(acc[ai][1][m][0], acc[ai][1][m][1]), fr, a, b);
                bf16_t* rp = base + (size_t)(ai * HALF + m * 16) * ldc;
                if (PUB) { st_wt16(rp, a); st_wt16(rp + (size_t)8 * ldc, b); }
                else { __builtin_nontemporal_store(a, (u32x4*)rp); __builtin_nontemporal_store(b, (u32x4*)(rp + (size_t)8 * ldc)); } }
    }
};
typedef EpiPlainBf16T<false> EpiPlainBf16;
struct EpiResid {
    static constexpr bool PERM = true; GM_NO_EPI_SIDE
    static constexpr bool PUBLISH = true;
    bf16_t* X; const float* rstd; unsigned* ready;
    DI void publish(int pm, int lane) const { if (lane == 0) (void)__hip_atomic_fetch_add(ready + pm * 16, 1u, __ATOMIC_RELAXED, __HIP_MEMORY_SCOPE_AGENT); }
    DI static u32x4 addrow(const u32x4& x, const u32x4& d, float inv) {
        u32x4 w;
        w.x = cvt_pk_bf16(bf_lo(x.x) * inv + bf_lo(d.x), bf_hi(x.x) * inv + bf_hi(d.x)); w.y = cvt_pk_bf16(bf_lo(x.y) * inv + bf_lo(d.y), bf_hi(x.y) * inv + bf_hi(d.y));
        w.z = cvt_pk_bf16(bf_lo(x.z) * inv + bf_lo(d.z), bf_hi(x.z) * inv + bf_hi(d.z)); w.w = cvt_pk_bf16(bf_lo(x.w) * inv + bf_lo(d.w), bf_hi(x.w) * inv + bf_hi(d.w));
        return w;
    }
    DI void operator()(const f32x4 (&acc)[2][2][4][2], const Unit& u, int wr, int wc, int fr, int fq, LAS unsigned char* side) const {
        const int row0 = u.pm * BM + wr * 64 + (fr >> 1);
        bf16_t* base = X + (size_t)row0 * 1024 + u.pn * BM + wc * 64 + 32 * (fr & 1) + 8 * fq;
        u32x4 da[8], db[8];
#pragma unroll
        for (int ai = 0; ai < 2; ++ai)
#pragma unroll
            for (int m = 0; m < 4; ++m) xchg_lines(pack_piece(acc[ai][0][m][0], acc[ai][0][m][1]), pack_piece(acc[ai][1][m][0], acc[ai][1][m][1]), fr, da[ai * 4 + m], db[ai * 4 + m]);
        u32x4 xa[8], xb_[8]; float ia[8], ib[8];
#pragma unroll
        for (int ai = 0; ai < 2; ++ai)
#pragma unroll
            for (int m = 0; m < 4; ++m) { const int i = ai * 4 + m; const bf16_t* rp = base + (size_t)(ai * HALF + m * 16) * 1024;
                xa[i] = *(const u32x4*)rp; xb_[i] = *(const u32x4*)(rp + (size_t)8 * 1024); ia[i] = rstd[row0 + ai * HALF + m * 16]; ib[i] = rstd[row0 + ai * HALF + m * 16 + 8]; }
#pragma unroll
        for (int i = 0; i < 8; ++i) asm volatile("" :: "v"(xa[i]), "v"(xb_[i]), "v"(ia[i]), "v"(ib[i]));
#pragma unroll
        for (int ai = 0; ai < 2; ++ai)
#pragma unroll
            for (int m = 0; m < 4; ++m) { const int i = ai * 4 + m; bf16_t* rp = base + (size_t)(ai * HALF + m * 16) * 1024;
                st_wt16(rp, addrow(xa[i], da[i], 1.0f / ia[i])); st_wt16(rp + (size_t)8 * 1024, addrow(xb_[i], db[i], 1.0f / ib[i])); }
    }
};
struct EpiQK {
    static constexpr bool PERM = true; GM_NO_EPI_SIDE GM_NO_EPI_PUB
    bf16_t* O; unsigned* kmax;
    DI void operator()(const f32x4 (&acc)[2][2][4][2], const Unit& u, int wr, int wc, int fr, int fq, LAS unsigned char* side) const {
        bf16_t* base = O + (size_t)(u.pm * BM + wr * 64 + (fr >> 1)) * 3072 + u.pn * BM + wc * 64 + 32 * (fr & 1) + 8 * fq;
        float pm[2] = {0.f, 0.f};
        const bool iskey = (u.pn >= 4 && u.pn < 8);
#pragma unroll
        for (int ai = 0; ai < 2; ++ai)
#pragma unroll
            for (int m = 0; m < 4; ++m) { u32x4 a, b; xchg_lines(pack_piece(acc[ai][0][m][0], acc[ai][0][m][1]), pack_piece(acc[ai][1][m][0], acc[ai][1][m][1]), fr, a, b);
                bf16_t* rp = base + (size_t)(ai * HALF + m * 16) * 3072;
                __builtin_nontemporal_store(a, (u32x4*)rp); __builtin_nontemporal_store(b, (u32x4*)(rp + (size_t)8 * 3072));
                if (iskey) {
#pragma unroll
                for (int bj = 0; bj < 2; ++bj) { const f32x4 v0 = acc[ai][bj][m][0], v1 = acc[ai][bj][m][1];
                    float s = v0[0] * v0[0] + v0[1] * v0[1] + v0[2] * v0[2] + v0[3] * v0[3] + v1[0] * v1[0] + v1[1] * v1[1] + v1[2] * v1[2] + v1[3] * v1[3];
                    s = xor16_sum(s); s = xor32_sum(s);
                    pm[bj] = fmaxf(pm[bj], s); } } }
        if (iskey) {
#pragma unroll
            for (int bj = 0; bj < 2; ++bj) { float v = pm[bj];
                v = fmaxf(v, __shfl_xor(v, 1)); v = fmaxf(v, __shfl_xor(v, 2)); v = fmaxf(v, __shfl_xor(v, 4)); v = fmaxf(v, __shfl_xor(v, 8));
                const int col = (u.pn - 4) * 256 + wc * 64 + bj * 32;
                if (fr == 0 && fq == 0) atomicMax(kmax + (((u.pm >> 3) * 8 + (col >> 7)) * 4 + ((col >> 5) & 3)), __float_as_uint(v)); }
        }
    }
};
template <int FULL> struct EpiProbeLines {
    static constexpr bool PERM = true; GM_NO_EPI_SIDE GM_NO_EPI_PUB
    bf16_t* O; int ldc;
    DI void operator()(const f32x4 (&acc)[2][2][4][2], const Unit& u, int wr, int wc, int fr, int fq, LAS unsigned char* side) const {
        const int lane = fq * 16 + fr;
#pragma unroll
        for (int ai = 0; ai < 2; ++ai)
#pragma unroll
            for (int m = 0; m < 4; ++m) {
#pragma unroll
                for (int bj = 0; bj < 2; ++bj) { const u32x4 w = pack_piece(acc[ai][bj][m][0], acc[ai][bj][m][1]);
                    bf16_t* dst = O + (size_t)(u.pm * BM + wr * 64 + ai * HALF + m * 16 + 8 * bj + (lane >> 3)) * ldc + u.pn * BM + wc * 64 + 8 * (lane & 7);
                    *(u32x4*)dst = w; } }
    }
};
struct EpiNone {
    static constexpr bool PERM = true; GM_NO_EPI_SIDE GM_NO_EPI_PUB
    DI void operator()(const f32x4 (&acc)[2][2][4][2], const Unit& u, int wr, int wc, int fr, int fq, LAS unsigned char* side) const {
#pragma unroll
        for (int ai = 0; ai < 2; ++ai)
#pragma unroll
            for (int m = 0; m < 4; ++m)
#pragma unroll
                for (int bj = 0; bj < 2; ++bj) { asm volatile("" :: "v"(acc[ai][bj][m][0]), "v"(acc[ai][bj][m][1])); }
    }
};
}
struct MegaParams {
    const float* in[29];
    float* out;
    unsigned* ctl;
    bf16_t *WinN, *WinT, *Wout, *Wqkv, *Wo, *Wup, *Wdn, *Wr;
    bf16_t* xb; float* rstd; float* ipfp;
    bf16_t *P1, *PT;
    bf16_t *act, *ybuf;
    bf16_t* Yb;
    bf16_t* dA; bf16_t* hB;
    int* lists; float* slot_rs; float* slot_gw;
    int ph_lo, ph_hi; unsigned prep_mask; int pad;
};
#define CTL_CNT(l) (XCD_BAR_WORDS + 32 * (l))
#define CTL_QUEUE (XCD_BAR_WORDS + 64)
#define CTL_MREADY(l, m) (4096 + ((l) * 384 + (m)) * 16)
#define CTL_DREADY(l, m) (16384 + ((l) * 128 + (m)) * 16)
#define CTL_YREADY(m) (20480 + (m) * 16)
#define CTL_KMAX 3584
#define MEGA_LDS_BYTES (gm::STAGE_BYTES + 16384)
#define MISC_OFF gm::STAGE_BYTES

DI float4 ld_nt4(const float* q) { const f32x4 v = __builtin_nontemporal_load((const f32x4*)q); return make_float4(v[0], v[1], v[2], v[3]); }
DI void prep_group4(LAS float* tl, const float* src, int ldsrc, int col0, int k0, const float* gain, float scale, bf16_t* dst, int K, int row0, int ncols = 64) {
    const int tid = opaque_tid();
    {
        const int kk = tid >> 4, c4 = (tid & 15) * 4;
        float4 v[8];
        if (c4 < ncols) {
#pragma unroll
            for (int q = 0; q < 8; ++q) v[q] = ld_nt4(src + (size_t)(k0 + kk + 32 * q) * ldsrc + col0 + c4);
#pragma unroll
            for (int q = 0; q < 8; ++q) { const int k = kk + 32 * q; const float g = (gain ? gain[k0 + k] : 1.0f) * scale;
                tl[k * 65 + c4 + 0] = v[q].x * g; tl[k * 65 + c4 + 1] = v[q].y * g; tl[k * 65 + c4 + 2] = v[q].z * g; tl[k * 65 + c4 + 3] = v[q].w * g; }
        }
    }
    __syncthreads();
    {
        const int n = tid >> 3, k8 = tid & 7;
        if (n < ncols)
#pragma unroll
        for (int q = 0; q < 4; ++q) { const int ks = (k8 + 8 * q) * 8;
            float v[8];
#pragma unroll
            for (int j = 0; j < 8; ++j) v[j] = tl[(ks + j) * 65 + n];
            u32x4 w; w.x = cvt_pk_bf16(v[0], v[1]); w.y = cvt_pk_bf16(v[2], v[3]); w.z = cvt_pk_bf16(v[4], v[5]); w.w = cvt_pk_bf16(v[6], v[7]);
            *(u32x4*)(dst + (size_t)(row0 + n) * K + k0 + ks) = w; }
    }
    __syncthreads();
}
#define MOE_PREP_GROUPS 6144
#define AUX_PREP_GROUPS 320
DI void moe_prep_group(const MegaParams& p, LAS float* tl, int g) {
    if (g < 4096) { const int mat = g >> 6, rt = (g >> 2) & 15, kq = g & 3, r0 = rt * 64, pn = r0 >> 8, wc = (r0 & 255) >> 6;
        const float* src = p.in[26] + (size_t)mat * 1024 * 1024; const float* gn = p.in[2] + (mat >> 5) * D_; bf16_t* dst = p.Wup + (size_t)mat * 1024 * 1024;
        prep_group4(tl, src, 1024, 128 * pn + 32 * wc, kq * 256, gn, 1.0f, dst, 1024, r0, 32);
        prep_group4(tl, src, 1024, 512 + 128 * pn + 32 * wc, kq * 256, gn, 1.0f, dst, 1024, r0 + 32, 32); }
    else { const int h = g - 4096, mat = h >> 5, rt = (h >> 1) & 15, kq = h & 1;
        prep_group4(tl, p.in[27] + (size_t)mat * 512 * 1024, 1024, rt * 64, kq * 256, nullptr, 1.0f, p.Wdn + (size_t)mat * 1024 * 512, 512, rt * 64); }
}
DI void aux_prep_group(const MegaParams& p, LAS float* tl, int t) {
    if (t < 64) { const int rt = t >> 2, kq = t & 3; prep_group4(tl, p.in[4], 1024, rt * 64, kq * 256, nullptr, 1.0f, p.Wout, 1024, rt * 64); }
    else if (t < 256) { const int u = t - 64, rt = u >> 2, kq = u & 3, r0 = rt * 64; prep_group4(tl, p.in[15], 3072, r0, kq * 256, p.in[1] + D_, r0 < 1024 ? 0.125f : 1.0f, p.Wqkv, 1024, r0); }
    else { const int u = t - 256, rt = u >> 2, kq = u & 3; prep_group4(tl, p.in[16], 1024, rt * 64, kq * 256, nullptr, 1.0f, p.Wo, 1024, rt * 64); }
}
DI void phase_prep(const MegaParams& p, LAS unsigned char* lds) {
    LAS float* tl = (LAS float*)lds;
    const int G = gridDim.x, bid = blockIdx.x, tid = opaque_tid();
    const unsigned mask = p.prep_mask;
    const float KS = 0.08838834764831845f;
    if (mask & 1u) for (int t = bid; t < 48 * 4; t += G) { const int rt = t >> 2, kq = t & 3, r0 = rt * 64;
        prep_group4(tl, p.in[3], PROJ_N, r0, kq * 256, p.in[1], (r0 >= 1536 && r0 < 2048) ? KS : 1.0f, p.WinN, 1024, r0); }
    if (mask & 4u) for (int t = bid; t < 16 * 4; t += G) { const int rt = t >> 2, kq = t & 3; prep_group4(tl, p.in[4], 1024, rt * 64, kq * 256, nullptr, 1.0f, p.Wout, 1024, rt * 64); }
    if (mask & 8u) for (int t = bid; t < 48 * 4; t += G) { const int rt = t >> 2, kq = t & 3, r0 = rt * 64;
        prep_group4(tl, p.in[15], 3072, r0, kq * 256, p.in[1] + D_, r0 < 1024 ? 0.125f : 1.0f, p.Wqkv, 1024, r0); }
    if (mask & 16u) for (int t = bid; t < 16 * 4; t += G) { const int rt = t >> 2, kq = t & 3; prep_group4(tl, p.in[16], 1024, rt * 64, kq * 256, nullptr, 1.0f, p.Wo, 1024, rt * 64); }
    if (mask & 32u) for (int g = bid; g < MOE_PREP_GROUPS; g += G) moe_prep_group(p, tl, g);
    if (mask & 128u) {
        LAS float* tr = (LAS float*)lds;
        for (int kb = bid; kb < D_ / 4; kb += G) { const int k0 = kb * 4;
            __syncthreads();
            if (tid < 64) { const int l = tid >> 5, kk = (tid >> 3) & 3, c = tid & 7; const float4 v = *(const float4*)(p.in[24] + (size_t)l * 1024 * 32 + (size_t)(k0 + kk) * 32 + c * 4); const float g = p.in[2][l * D_ + k0 + kk];
                LAS float* d = tr + (l * 4 + kk) * 40 + 4 + c * 4; d[0] = v.x * g; d[1] = v.y * g; d[2] = v.z * g; d[3] = v.w * g; }
            else if (tid < 72) { const int u = tid - 64, l = u >> 2, kk = u & 3; const float4 v = *(const float4*)(p.in[22] + (size_t)l * 1024 * 4 + (size_t)(k0 + kk) * 4); const float g = p.in[2][l * D_ + k0 + kk];
                LAS float* d = tr + (l * 4 + kk) * 40; d[0] = v.x * g; d[1] = v.y * g; d[2] = v.z * g; d[3] = v.w * g; }
            __syncthreads();
            if (tid < 96) { const int l = tid / 48, r = tid % 48; float w4[4];
#pragma unroll
                for (int kk = 0; kk < 4; ++kk) w4[kk] = r < 36 ? tr[(l * 4 + kk) * 40 + r] : 0.f;
                u32x2 w; w.x = cvt_pk_bf16(w4[0], w4[1]); w.y = cvt_pk_bf16(w4[2], w4[3]);
                *(u32x2*)(p.Wr + (size_t)(l * 48 + r) * 1024 + k0) = w; }
        }
        __syncthreads();
    }
    if (mask & 256u) {
        LAS float* wg = (LAS float*)lds;
        __syncthreads();
        for (int k = tid; k < 1024; k += 512) {
            const float4 a = *(const float4*)(p.in[3] + (size_t)k * PROJ_N + 3072), b = *(const float4*)(p.in[3] + (size_t)k * PROJ_N + 3076); const float g = p.in[1][k];
            wg[k] = a.x * g; wg[1024 + k] = a.y * g; wg[2048 + k] = a.z * g; wg[3072 + k] = a.w * g; wg[4096 + k] = b.x * g; wg[5120 + k] = b.y * g; wg[6144 + k] = b.z * g; wg[7168 + k] = b.w * g; }
        __syncthreads();
        const int wave = tid >> 6, lane = tid & 63; const float* x = p.in[0];
        for (int rbase = bid * 128 + wave * 16; rbase < T_; rbase += G * 128) {
        float4 nv[2][4];
        {
#pragma unroll
            for (int q = 0; q < 2; ++q)
#pragma unroll
                for (int i = 0; i < 4; ++i) nv[q][i] = ld_nt4(x + (size_t)(rbase + q) * D_ + (lane + 64 * i) * 4);
        }
        for (int r4 = 0; r4 < 16; r4 += 2) {
            float4 v[2][4]; float ss[2]; float dot[2][8];
#pragma unroll
            for (int q = 0; q < 2; ++q)
#pragma unroll
                for (int i = 0; i < 4; ++i) v[q][i] = nv[q][i];
            if (r4 + 2 < 16) {
#pragma unroll
                for (int q = 0; q < 2; ++q)
#pragma unroll
                    for (int i = 0; i < 4; ++i) nv[q][i] = ld_nt4(x + (size_t)(rbase + r4 + 2 + q) * D_ + (lane + 64 * i) * 4);
            }
#pragma unroll
            for (int q = 0; q < 2; ++q) { ss[q] = 0.f;
#pragma unroll
                for (int j = 0; j < 8; ++j) dot[q][j] = 0.f; }
#pragma unroll
            for (int i = 0; i < 4; ++i) {
#pragma unroll
                for (int q = 0; q < 2; ++q) ss[q] += v[q][i].x * v[q][i].x + v[q][i].y * v[q][i].y + v[q][i].z * v[q][i].z + v[q][i].w * v[q][i].w;
#pragma unroll
                for (int j = 0; j < 8; ++j) { const f32x4 g4 = *(const LAS f32x4*)(wg + j * 1024 + (lane + 64 * i) * 4);
#pragma unroll
                    for (int q = 0; q < 2; ++q) dot[q][j] += v[q][i].x * g4[0] + v[q][i].y * g4[1] + v[q][i].z * g4[2] + v[q][i].w * g4[3]; }
            }
#pragma unroll
            for (int q = 0; q < 2; ++q) {
                ss[q] = wave_sum_uniform(ss[q]);
#pragma unroll
                for (int j = 0; j < 8; ++j) dot[q][j] = wave_sum_uniform(dot[q][j]);
                const int row = rbase + r4 + q;
                const float rs = rsqrtf(ss[q] * (1.0f / D_) + EPS_);
#pragma unroll
                for (int i = 0; i < 4; ++i) { u32x2 w; w.x = cvt_pk_bf16(v[q][i].x * rs, v[q][i].y * rs); w.y = cvt_pk_bf16(v[q][i].z * rs, v[q][i].w * rs); *(u32x2*)(p.xb + (size_t)row * D_ + (lane + 64 * i) * 4) = w; }
                if (lane == 0) { p.rstd[row] = rs;
                    f32x4 a = {dot[q][0] * rs, dot[q][1] * rs, dot[q][2] * rs, dot[q][3] * rs}, b = {dot[q][4] * rs, dot[q][5] * rs, dot[q][6] * rs, dot[q][7] * rs};
                    *(f32x4*)(p.ipfp + (size_t)row * 8) = a; *(f32x4*)(p.ipfp + (size_t)row * 8 + 4) = b; }
            }
        }
        }
        __syncthreads();
    }
}

DI void phase_router(const MegaParams& p, LAS unsigned char* lds, const bf16_t* Wr, const float* bg, const float* be, unsigned* gcnt, unsigned* dready) {
    LAS float* lg = (LAS float*)lds;
    LAS float* rsl = (LAS float*)(lds + 8 * 16 * 48 * 4);
    LAS int* lcnt = (LAS int*)(lds + 8 * 16 * 48 * 4 + 8 * 16 * 4);
    LAS int* lbase = lcnt + 32;
    const int tid = opaque_tid(), wave = tid >> 6, lane = tid & 63, fr = lane & 15, g = lane >> 4;
    LAS unsigned char* wl = lds + 25600;
    __syncthreads();
    for (int i = tid; i < 48 * 128; i += 512) { const int r = i >> 7, c8 = (i & 127) * 8; *(LAS u32x4*)(wl + (r * 1032 + c8) * 2) = *(const u32x4*)(Wr + (size_t)r * D_ + c8); }
    __syncthreads();
    for (int base = blockIdx.x * 128; base < T_; base += gridDim.x * 128) {
        if (wave == 0) poll_acquire(dready + (base >> 8) * 16, 32u);
        __syncthreads();
        if (tid < 32) lcnt[tid] = 0;
        const int r0 = base + wave * 16;
        f32x4 acc[3];
#pragma unroll
        for (int n = 0; n < 3; ++n) acc[n] = (f32x4){0.f, 0.f, 0.f, 0.f};
        float ss = 0.f;
        const bf16_t* xo = p.xb + (size_t)(r0 + fr) * D_ + 8 * g;
        const LAS unsigned char* wp = wl + (fr * 1032 + 8 * g) * 2;
#pragma unroll 8
        for (int kk = 0; kk < 32; ++kk) {
            const u32x4 hv = *(const u32x4*)(xo + 32 * kk);
            const float a0 = bf_lo(hv.x), a1 = bf_hi(hv.x), a2 = bf_lo(hv.y), a3 = bf_hi(hv.y), a4 = bf_lo(hv.z), a5 = bf_hi(hv.z), a6 = bf_lo(hv.w), a7 = bf_hi(hv.w);
            ss += a0 * a0 + a1 * a1 + a2 * a2 + a3 * a3 + a4 * a4 + a5 * a5 + a6 * a6 + a7 * a7;
            const bf16x8 af = __builtin_bit_cast(bf16x8, hv);
#pragma unroll
            for (int n = 0; n < 3; ++n) { const bf16x8 bfr = *(const LAS bf16x8*)(wp + (n * 16 * 1032 + 32 * kk) * 2); acc[n] = __builtin_amdgcn_mfma_f32_16x16x32_bf16(af, bfr, acc[n], 0, 0, 0); }
        }
        ss += __shfl_xor(ss, 16); ss += __shfl_xor(ss, 32);
        const float rs = rsqrtf(ss * (1.0f / D_) + EPS_);
        if (g == 0) { p.rstd[r0 + fr] = rs; rsl[wave * 16 + fr] = rs; }
        __syncthreads();
#pragma unroll
        for (int n = 0; n < 3; ++n) { const int col = 16 * n + fr; const float bias = col < 4 ? bg[col] : (col < 36 ? be[col - 4] : 0.f);
#pragma unroll
            for (int r = 0; r < 4; ++r) lg[(wave * 16 + 4 * g + r) * 48 + col] = acc[n][r] * rsl[wave * 16 + 4 * g + r] + bias; }
        __syncthreads();
        int x0 = 0, x1 = 0, p0 = 0, p1 = 0; float w0 = 0.f, w1 = 0.f;
        if (lane < 16) {
            const LAS float* L = lg + (wave * 16 + lane) * 48;
            int gi = 0; float gmx = L[0];
            for (int j = 1; j < 4; ++j) if (L[j] > gmx) { gmx = L[j]; gi = j; }
            float gs = 0.f; for (int j = 0; j < 4; ++j) gs += expf(L[j] - gmx);
            const float gw = 1.0f / gs;
            const LAS float* E = L + 4 + gi * 8;
            int i0 = 0; float v0 = E[0];
            for (int j = 1; j < 8; ++j) if (E[j] > v0) { v0 = E[j]; i0 = j; }
            int i1 = -1; float v1 = -INFINITY;
            for (int j = 0; j < 8; ++j) if (j != i0 && E[j] > v1) { v1 = E[j]; i1 = j; }
            const float e1 = expf(v1 - v0);
            w0 = gw / (1.0f + e1); w1 = gw * e1 / (1.0f + e1);
            x0 = gi * 8 + i0; x1 = gi * 8 + i1;
            p0 = atomicAdd((int*)&lcnt[x0], 1); p1 = atomicAdd((int*)&lcnt[x1], 1);
        }
        __syncthreads();
        if (tid < 32) { const int c = lcnt[tid]; lbase[tid] = c ? (int)atomicAdd(&gcnt[tid], (unsigned)c) : 0; }
        __syncthreads();
        if (lane < 16) {
            const int t = r0 + lane;
            const size_t i0 = (size_t)x0 * T_ + lbase[x0] + p0, i1 = (size_t)x1 * T_ + lbase[x1] + p1; const float rsv = rsl[wave * 16 + lane];
            p.lists[i0] = 2 * t; p.lists[i1] = 2 * t + 1; p.slot_rs[i0] = rsv; p.slot_rs[i1] = rsv; p.slot_gw[i0] = w0; p.slot_gw[i1] = w1;
        }
        __syncthreads();
    }
}

struct MoeTables { LAS int* cnt; LAS int* tp; LAS int* poff; int ntiles; };
DI MoeTables moe_tables(LAS unsigned char* misc, const unsigned* gcnt) {
    MoeTables t; t.cnt = (LAS int*)misc; t.tp = t.cnt + 32; t.poff = t.tp + 33;
    __syncthreads();
    if (threadIdx.x < 32) t.cnt[threadIdx.x] = (int)__hip_atomic_load(gcnt + threadIdx.x, __ATOMIC_RELAXED, __HIP_MEMORY_SCOPE_AGENT);
    __syncthreads();
    if (threadIdx.x == 0) { int r = 0; for (int e = 0; e < 32; ++e) { const int c = t.cnt[e]; t.tp[e] = r; t.poff[e] = r * 256; r += (c + 255) >> 8; } t.tp[32] = r; }
    __syncthreads();
    t.ntiles = t.tp[32];
    return t;
}
struct MoeUpSched {
    GM_NO_SCHED_WAIT
    static constexpr bool GATHER = true;
    const bf16_t* xb; const bf16_t* W; const int* lists; MoeTables tb; int G, c; int tid16;
    DI bool next(int i, gm::Unit& u) const {
        const int L = i * G + c; if (L >= tb.ntiles * 4) return false;
        const int mtile = L >> 2, pn = L & 3; int e = 0;
        for (int j = 1; j < 32; ++j) if (tb.tp[j] <= mtile) e = j;
        e = __builtin_amdgcn_readfirstlane(e);
        const int mt = __builtin_amdgcn_readfirstlane(mtile - tb.tp[e]), cnt = __builtin_amdgcn_readfirstlane(tb.cnt[e]);
        u.aB = (const char*)xb; u.bB = (const char*)W + ((size_t)e * 1024 + (size_t)pn * 256) * 1024 * 2; u.pm = mtile; u.pn = pn; u.e = e; u.cnt = cnt - mt * 256; u.mt = mt;
        return true;
    }
    DI void va_direct(const gm::Unit& u, unsigned (&va)[2][2]) const {
        int tk[2][2];
#pragma unroll
        for (int q = 0; q < 2; ++q) { int R, C; gm::stage_rc(opaque_tid() * 16 + q * 8192, R, C); R = (R & ~15) + gm::rho16(R & 15);
#pragma unroll
            for (int h = 0; h < 2; ++h) { int r = h * 128 + R; r = r < u.cnt ? r : u.cnt - 1; tk[h][q] = lists[(size_t)u.e * T_ + u.mt * 256 + r]; } }
#pragma unroll
        for (int q = 0; q < 2; ++q) { int R, C; gm::stage_rc(opaque_tid() * 16 + q * 8192, R, C);
#pragma unroll
            for (int h = 0; h < 2; ++h) va[h][q] = (unsigned)((tk[h][q] >> 1) * 1024 + C) * 2u; }
    }
    DI void side_issue(LAS unsigned char* side, const gm::Unit& nx, int lane) const {
        __builtin_amdgcn_global_load_lds((const unsigned*)(lists + (size_t)nx.e * T_ + nx.mt * 256 + lane * 4), (LAS unsigned*)side, 16, 0, 0);
    }
    DI void fill_va(LAS unsigned char* side, const gm::Unit& u, unsigned (&va)[2][2], int h, int tidr) const {
        const LAS int* sl = (const LAS int*)side;
#pragma unroll
        for (int q = 0; q < 2; ++q) { int R, C; gm::stage_rc(tidr * 16 + q * 8192, R, C); R = (R & ~15) + gm::rho16(R & 15);
            int r = h * 128 + R; r = r < u.cnt ? r : u.cnt - 1; const int tk = sl[r]; va[h][q] = (unsigned)((tk >> 1) * 1024 + C) * 2u; }
    }
};
struct MoeDownSched {
    static constexpr bool GATHER = false;
    static constexpr bool WAITS = true;
    const bf16_t* act; const bf16_t* W; MoeTables tb; int G, c; int tid16; unsigned* ready; unsigned* tmo;
    DI void a_ready(int pm, int wid) const {
        if (wid == 0) poll_acquire(ready + pm * 16, 32u);
        asm volatile("" ::: "memory"); __builtin_amdgcn_s_barrier(); asm volatile("" ::: "memory");
    }
    DI bool next(int i, gm::Unit& u) const {
        const int U = tb.ntiles * 4, rup = (U + G - 1) / G, nlate = U - (rup - 1) * G;
        int L;
        if (rup >= 3 && nlate > 0 && nlate < G) {
            const int E = G - nlate, v = c >= nlate ? c - nlate : c + E, full = rup - 2;
            if (i < full) L = i * G + v; else { if (v >= E) return false; L = full * G + (i - full) * E + v; }
        } else L = i * G + (G - 1 - c);
        if (L >= U) return false;
        const int mtile = L >> 2, pn = L & 3; int e = 0;
        for (int j = 1; j < 32; ++j) if (tb.tp[j] <= mtile) e = j;
        e = __builtin_amdgcn_readfirstlane(e);
        const int mt = __builtin_amdgcn_readfirstlane(mtile - tb.tp[e]), cnt = __builtin_amdgcn_readfirstlane(tb.cnt[e]);
        u.aB = (const char*)act + (size_t)mtile * 256 * 512 * 2; u.bB = (const char*)W + ((size_t)e * 1024 + (size_t)pn * 256) * 512 * 2; u.pm = mtile; u.pn = pn; u.e = e; u.cnt = cnt - mt * 256; u.mt = mt;
        return true;
    }
    DI void va_direct(const gm::Unit&, unsigned (&va)[2][2]) const { int R, C; gm::stage_rc(opaque_tid() * 16, R, C); R = (R & ~15) + gm::rho16(R & 15); const unsigned v = (unsigned)(R * 512 + C) * 2u; va[0][0] = v; va[0][1] = v; va[1][0] = v; va[1][1] = v; }
    GM_NO_SCHED_SIDE
};
struct EpiSwiglu {
    static constexpr bool PERM = true;
    bf16_t* act; const float* slot_rs; LAS int* tp; unsigned* ready;
    static constexpr bool PUBLISH = true;
    DI void publish(int pm, int lane) const { if (lane == 0) (void)__hip_atomic_fetch_add(ready + pm * 16, 1u, __ATOMIC_RELAXED, __HIP_MEMORY_SCOPE_AGENT); }
    DI void side_issue(LAS unsigned char* side, const gm::Unit& u, int lane) const {
        __builtin_amdgcn_global_load_lds((const unsigned*)(slot_rs + (size_t)u.e * T_ + u.mt * 256 + lane * 4), (LAS unsigned*)(side + 1024), 16, 0, 0);
    }
    DI void operator()(const f32x4 (&acc)[2][2][4][2], const gm::Unit& u, int wr, int wc, int fr, int fq, LAS unsigned char* side) const {
        const LAS float* srow = (const LAS float*)(side + 1024);
        int fro = fr, fqo = fq; asm volatile("" : "+v"(fro), "+v"(fqo));
        float srs[8];
#pragma unroll
        for (int q = 0; q < 8; ++q) { const int rl = (q >> 2) * 128 + wr * 64 + (q & 3) * 16 + gm::rho16(fro); const int rr = rl < u.cnt ? rl : u.cnt - 1; srs[q] = srow[rr]; }
#pragma unroll
        for (int ai = 0; ai < 2; ++ai)
#pragma unroll
            for (int m = 0; m < 4; ++m) {
                const int rl = ai * 128 + wr * 64 + m * 16 + gm::rho16(fro);
                const float s = srs[ai * 4 + m];
                float o[8];
#pragma unroll
                for (int n = 0; n < 2; ++n)
#pragma unroll
                    for (int j = 0; j < 4; ++j) { const float a = acc[ai][0][m][n][j] * s, b = acc[ai][1][m][n][j] * s; o[4 * n + j] = a * b * __builtin_amdgcn_rcpf(1.0f + __expf(-a)); }
                u32x4 w; w.x = cvt_pk_bf16(o[0], o[1]); w.y = cvt_pk_bf16(o[2], o[3]); w.z = cvt_pk_bf16(o[4], o[5]); w.w = cvt_pk_bf16(o[6], o[7]);
                st_wt16(act + (size_t)(u.pm * 256 + rl) * 512 + u.pn * 128 + wc * 32 + 8 * fqo, w);
            }
    }
};
struct EpiMoeDown {
    GM_NO_EPI_PUB static constexpr bool PERM = true;
    bf16_t* ybuf; const int* lists; const float* slot_gw; LAS int* tp;
    DI void side_issue(LAS unsigned char* side, const gm::Unit& u, int lane) const {
        const size_t li = (size_t)u.e * T_ + u.mt * 256 + lane * 4;
        __builtin_amdgcn_global_load_lds((const unsigned*)(lists + li), (LAS unsigned*)(side + 1024), 16, 0, 0);
        __builtin_amdgcn_global_load_lds((const unsigned*)(slot_gw + li), (LAS unsigned*)(side + 2048), 16, 0, 0);
    }
    DI void operator()(const f32x4 (&acc)[2][2][4][2], const gm::Unit& u, int wr, int wc, int fr, int fq, LAS unsigned char* side) const {
        const LAS int* stk = (const LAS int*)(side + 1024); const LAS float* sgwp = (const LAS float*)(side + 2048);
        int fro = fr, fqo = fq; asm volatile("" : "+v"(fro), "+v"(fqo));
        int tks[8]; float sgw[8];
#pragma unroll
        for (int q = 0; q < 8; ++q) { const int rl = (q >> 2) * 128 + wr * 64 + (q & 3) * 16 + gm::rho16(fro); const int rr = rl < u.cnt ? rl : u.cnt - 1; tks[q] = stk[rr]; sgw[q] = sgwp[rr]; }
        const int coff = u.pn * 256 + wc * 64 + 32 * (fro & 1) + 8 * fqo;
#pragma unroll
        for (int ai = 0; ai < 2; ++ai)
#pragma unroll
            for (int m = 0; m < 4; ++m) {
                const float s = sgw[ai * 4 + m]; const int tk = tks[ai * 4 + m];
                const int tkp = (int)gm::dpp_ror8((unsigned)tk);
                u32x4 a, b; gm::xchg_lines(gm::pack_piece(acc[ai][0][m][0] * s, acc[ai][0][m][1] * s), gm::pack_piece(acc[ai][1][m][0] * s, acc[ai][1][m][1] * s), fro, a, b);
                const int rb = ai * 128 + wr * 64 + m * 16 + (fro >> 1);
                const int tkA = (fro & 1) == 0 ? tk : tkp, tkB = (fro & 1) == 0 ? tkp : tk;
                if (rb < u.cnt) __builtin_nontemporal_store(a, (u32x4*)(ybuf + (size_t)tkA * 1024 + coff));
                if (rb + 8 < u.cnt) __builtin_nontemporal_store(b, (u32x4*)(ybuf + (size_t)tkB * 1024 + coff));
            }
    }
};

template <int MODE>
DI void phase_combine(const MegaParams& p, void* hout_, const float* gfin) {
    float* hout = (float*)hout_;
    const int tid_ = opaque_tid(); const int wave = tid_ >> 6, lane = tid_ & 63;
    u32x4 nx[2][3];
    auto issue = [&](int r) {
#pragma unroll
        for (int i = 0; i < 2; ++i) { const int c = (lane + 64 * i) * 8;
            nx[i][0] = *(const u32x4*)(p.xb + (size_t)r * D_ + c); nx[i][1] = __builtin_nontemporal_load((const u32x4*)(p.ybuf + (size_t)(2 * r) * D_ + c)); nx[i][2] = __builtin_nontemporal_load((const u32x4*)(p.ybuf + (size_t)(2 * r + 1) * D_ + c)); } };
    const int rstep = gridDim.x * 8;
    int row = blockIdx.x * 8 + wave;
    if (row < T_) issue(row);
    for (; row < T_; row += rstep) {
        float v[16]; float ss = 0.f;
        u32x4 cu[2][3];
#pragma unroll
        for (int i = 0; i < 2; ++i)
#pragma unroll
            for (int q = 0; q < 3; ++q) cu[i][q] = nx[i][q];
        if (row + rstep < T_) issue(row + rstep);
#pragma unroll
        for (int i = 0; i < 2; ++i) {
            const u32x4 hv = cu[i][0], a = cu[i][1], b = cu[i][2];
            v[8 * i + 0] = bf_lo(hv.x) + (bf_lo(a.x) + bf_lo(b.x)); v[8 * i + 1] = bf_hi(hv.x) + (bf_hi(a.x) + bf_hi(b.x));
            v[8 * i + 2] = bf_lo(hv.y) + (bf_lo(a.y) + bf_lo(b.y)); v[8 * i + 3] = bf_hi(hv.y) + (bf_hi(a.y) + bf_hi(b.y));
            v[8 * i + 4] = bf_lo(hv.z) + (bf_lo(a.z) + bf_lo(b.z)); v[8 * i + 5] = bf_hi(hv.z) + (bf_hi(a.z) + bf_hi(b.z));
            v[8 * i + 6] = bf_lo(hv.w) + (bf_lo(a.w) + bf_lo(b.w)); v[8 * i + 7] = bf_hi(hv.w) + (bf_hi(a.w) + bf_hi(b.w));
        }
#pragma unroll
        for (int j = 0; j < 16; ++j) ss += v[j] * v[j];
        ss = wave_sum_uniform(ss);
        const float rs = rsqrtf(ss * (1.0f / D_) + EPS_);
#pragma unroll
        for (int i = 0; i < 2; ++i) {
            const int c = (lane + 64 * i) * 8;
            if (MODE == 0) {
                u32x4 w; w.x = cvt_pk_bf16(v[8 * i] * rs, v[8 * i + 1] * rs); w.y = cvt_pk_bf16(v[8 * i + 2] * rs, v[8 * i + 3] * rs); w.z = cvt_pk_bf16(v[8 * i + 4] * rs, v[8 * i + 5] * rs); w.w = cvt_pk_bf16(v[8 * i + 6] * rs, v[8 * i + 7] * rs);
                *(u32x4*)(p.xb + (size_t)row * D_ + c) = w;
            } else {
                const float4 g0 = *(const float4*)(gfin + c), g1 = *(const float4*)(gfin + c + 4);
                __builtin_nontemporal_store((f32x4){v[8 * i] * rs * g0.x, v[8 * i + 1] * rs * g0.y, v[8 * i + 2] * rs * g0.z, v[8 * i + 3] * rs * g0.w}, (f32x4*)(hout + (size_t)row * D_ + c));
                __builtin_nontemporal_store((f32x4){v[8 * i + 4] * rs * g1.x, v[8 * i + 5] * rs * g1.y, v[8 * i + 6] * rs * g1.z, v[8 * i + 7] * rs * g1.w}, (f32x4*)(hout + (size_t)row * D_ + c + 4));
            }
        }
        if (MODE == 0 && lane == 0) p.rstd[row] = rs;
    }
}
#define LAMBDA_INIT_F 0.35550906759096926f
#define ATT_KSTR 136
#define ATT_VSTR 160
#define ATT_KBYTES (64 * ATT_KSTR * 2)
#define ATT_VBYTES (64 * ATT_VSTR * 2)
#define MFMA32(a, b, c) __builtin_amdgcn_mfma_f32_32x32x16_bf16((a), (b), (c), 0, 0, 0)
DI bf16x8 pack8(float a0, float a1, float a2, float a3, float a4, float a5, float a6, float a7) {
    u32x4 p; p.x = cvt_pk_bf16(a0, a1); p.y = cvt_pk_bf16(a2, a3); p.z = cvt_pk_bf16(a4, a5); p.w = cvt_pk_bf16(a6, a7);
    return __builtin_bit_cast(bf16x8, p);
}
typedef short tr4_t __attribute__((ext_vector_type(4)));
struct AttnPre { bf16x8 qf[4]; u32x4 kr0, kr1, vr0, vr1; };
DI void attn_issue(const MegaParams& p, int b, int h, int qb, AttnPre& R) {
    const int tid = opaque_tid(), wid = __builtin_amdgcn_readfirstlane(tid >> 6), lane = tid & 63, l31 = lane & 31, hh = lane >> 5;
    const int comp = wid >> 2, rg = wid & 3, nkt = 2 * qb + 2, q0 = qb * 128 + rg * 32;
    const size_t tokbase = (size_t)b * S_;
    const bf16_t* qp = p.P1 + (tokbase + q0 + l31) * 3072 + h * 128 + comp * 64 + 8 * hh;
#pragma unroll
    for (int ks = 0; ks < 4; ++ks) R.qf[ks] = *(const bf16x8*)(qp + 16 * ks);
    const int skey = tid >> 3, sseg = tid & 7;
    const bf16_t* kg0 = p.P1 + (tokbase + (size_t)(nkt - 1) * 64 + skey) * 3072 + 1024 + h * 128 + sseg * 8;
    R.kr0 = *(const u32x4*)(kg0); R.kr1 = *(const u32x4*)(kg0 + 64); R.vr0 = *(const u32x4*)(kg0 + 1024); R.vr1 = *(const u32x4*)(kg0 + 1024 + 64);
}
DI void attn_unit(const MegaParams& p, LAS unsigned char* lds, LAS unsigned char* misc, int b, int h, int qb, float lam, int force_lim, AttnPre& pre, bool has_next, int nb, int nh, int nqb, int& pubt) {
    const int tid = opaque_tid(), wid = __builtin_amdgcn_readfirstlane(tid >> 6), lane = tid & 63, l31 = lane & 31, hh = lane >> 5;
    const int comp = wid >> 2, rg = wid & 3, l15 = lane & 15, eh = (lane >> 4) & 1;
    const bf16_t* QK = p.P1;
    const float LOG2E = 1.4426950408889634f;
    const int q0 = qb * 128 + rg * 32, qc = q0 >> 6, Q0 = qc * 64, nkt = 2 * qb + 2;
    const size_t tokbase = (size_t)b * S_;
    const float slope = exp2f(-(float)(h + 1));
    LAS unsigned char* kbuf = lds; LAS unsigned char* vbuf = lds + 2 * ATT_KBYTES;
    LAS float* gl = (LAS float*)(misc + 4096);
    LAS unsigned char* qbuf = lds + 2 * ATT_KBYTES + 2 * ATT_VBYTES + wid * 4352 + lane * 16;
#pragma unroll
    for (int ks = 0; ks < 4; ++ks) *(LAS bf16x8*)(qbuf + ks * 1024) = pre.qf[ks];
    float qn;
    { float s2 = 0.f;
#pragma unroll
      for (int ks = 0; ks < 4; ++ks) { const u32x4 w = __builtin_bit_cast(u32x4, pre.qf[ks]);
          s2 += bf_lo(w.x) * bf_lo(w.x) + bf_hi(w.x) * bf_hi(w.x) + bf_lo(w.y) * bf_lo(w.y) + bf_hi(w.y) * bf_hi(w.y) + bf_lo(w.z) * bf_lo(w.z) + bf_hi(w.z) * bf_hi(w.z) + bf_lo(w.w) * bf_lo(w.w) + bf_hi(w.w) * bf_hi(w.w); }
      s2 = xor32_sum(s2); qn = __builtin_amdgcn_sqrtf(s2) * 1.001f; }
    const unsigned* kmx = p.ctl + CTL_KMAX + ((b * 8 + h) * 4 + comp * 2);
    const float kb = __builtin_amdgcn_sqrtf(__uint_as_float(__hip_atomic_load(kmx, __ATOMIC_RELAXED, __HIP_MEMORY_SCOPE_AGENT)) + __uint_as_float(__hip_atomic_load(kmx + 1, __ATOMIC_RELAXED, __HIP_MEMORY_SCOPE_AGENT))) * 1.02f;
    const float qk_ub = qn * kb;
    LAS int* votes = (LAS int*)(misc + 3072);
    const int skey = tid >> 3, sseg = tid & 7;
    const bf16_t* kg = QK + (tokbase + skey) * 3072 + 1024 + h * 128 + sseg * 8;
    const bf16_t* vg = QK + (tokbase + skey) * 3072 + 2048 + h * 128 + sseg * 8;
    const int klds = (skey * ATT_KSTR + sseg * 8) * 2, vlds = (skey * ATT_VSTR + sseg * 8) * 2;
    *(LAS u32x4*)(kbuf + klds) = pre.kr0; *(LAS u32x4*)(kbuf + klds + 128) = pre.kr1;
    *(LAS u32x4*)(vbuf + vlds) = pre.vr0; *(LAS u32x4*)(vbuf + vlds + 128) = pre.vr1;
    u32x4 sa0, sa1, sa2, sa3, sb0, sb1, sb2, sb3;
    { const bf16_t* kgn = kg + (size_t)(nkt - 2) * 64 * 3072; const bf16_t* vgn = vg + (size_t)(nkt - 2) * 64 * 3072;
      sb0 = *(const u32x4*)(kgn); sb1 = *(const u32x4*)(kgn + 64); sb2 = *(const u32x4*)(vgn); sb3 = *(const u32x4*)(vgn + 64); }
    __syncthreads();
    f32x16 O[4];
#pragma unroll
    for (int et = 0; et < 4; ++et)
#pragma unroll
        for (int i = 0; i < 16; ++i) O[et][i] = 0.f;
    float m = -1e30f, l = 0.f;
    int kt = nkt - 1, it = 0;
    int vs = 0;
    bf16x8 pf[2][2];
    bool pend = false;
#define ATT_VRD(F, VB, g) do { _Pragma("unroll") for (int s8 = 0; s8 < 2; ++s8) { \
        LAS unsigned char* vp = (VB) + ((32 * ((g) & 1) + 16 * s8 + 4 * hh + (l15 >> 2)) * ATT_VSTR + 32 * ((g) >> 1) + 16 * eh + 4 * (l15 & 3)) * 2; \
        const tr4_t lo = __builtin_amdgcn_ds_read_tr16_b64_v4i16((LAS tr4_t*)vp), hi = __builtin_amdgcn_ds_read_tr16_b64_v4i16((LAS tr4_t*)(vp + 8 * ATT_VSTR * 2)); \
        F[s8] = __builtin_shufflevector(lo, hi, 0, 1, 2, 3, 4, 5, 6, 7); } } while (0)
#define ATT_VMM(F, g) do { _Pragma("unroll") for (int s8 = 0; s8 < 2; ++s8) O[(g) >> 1] = MFMA32(F[s8], pf[(g) & 1][s8], O[(g) >> 1]); } while (0)
#define ATT_PV(VB) do { bf16x8 vfa[2], vfb[2]; LAS unsigned char* _vb = (VB); \
        ATT_VRD(vfa, _vb, 0); ATT_VRD(vfb, _vb, 1); __builtin_amdgcn_sched_barrier(0); \
        ATT_VMM(vfa, 0); __builtin_amdgcn_sched_barrier(0); ATT_VRD(vfa, _vb, 2); __builtin_amdgcn_sched_barrier(0); \
        ATT_VMM(vfb, 1); __builtin_amdgcn_sched_barrier(0); ATT_VRD(vfb, _vb, 3); __builtin_amdgcn_sched_barrier(0); \
        ATT_VMM(vfa, 2); __builtin_amdgcn_sched_barrier(0); ATT_VRD(vfa, _vb, 4); __builtin_amdgcn_sched_barrier(0); \
        ATT_VMM(vfb, 3); __builtin_amdgcn_sched_barrier(0); ATT_VRD(vfb, _vb, 5); __builtin_amdgcn_sched_barrier(0); \
        ATT_VMM(vfa, 4); __builtin_amdgcn_sched_barrier(0); ATT_VRD(vfa, _vb, 6); __builtin_amdgcn_sched_barrier(0); \
        ATT_VMM(vfb, 5); __builtin_amdgcn_sched_barrier(0); ATT_VRD(vfb, _vb, 7); __builtin_amdgcn_sched_barrier(0); \
        ATT_VMM(vfa, 6); __builtin_amdgcn_sched_barrier(0); ATT_VMM(vfb, 7); } while (0)
#define ATT_VSLOT(sl) (lds + ((sl) == 2 ? (2 * ATT_KBYTES + 2 * ATT_VBYTES + 34816) : (2 * ATT_KBYTES + (sl) * ATT_VBYTES)))
#define ATT_STEP(LD0, LD1, LD2, LD3, PK0, PK1, PK2, PK3) { \
        const int cur = it & 1; const int vnext = vs == 2 ? 0 : vs + 1, vprev = vs == 0 ? 2 : vs - 1; \
        if (kt >= 2) { const bf16_t* kgn = kg + (size_t)(kt - 2) * 64 * 3072; const bf16_t* vgn = vg + (size_t)(kt - 2) * 64 * 3072; \
            LD0 = *(const u32x4*)(kgn); LD1 = *(const u32x4*)(kgn + 64); LD2 = *(const u32x4*)(vgn); LD3 = *(const u32x4*)(vgn + 64); } \
        if (comp == 1 && pend) { ATT_PV(ATT_VSLOT(vprev)); pend = false; } \
        if (kt <= qc) { \
            LAS unsigned char* kb = kbuf + cur * ATT_KBYTES; \
            const bool diag = (kt == qc); \
            bf16x8 qfr[4]; \
            _Pragma("unroll") for (int ks = 0; ks < 4; ++ks) qfr[ks] = *(const LAS bf16x8*)(qbuf + ks * 1024); \
            f32x16 s[2]; \
            _Pragma("unroll") for (int sub = 0; sub < 2; ++sub) { \
                const float kb0 = diag ? 0.f : slope * (float)(kt * 64 + 32 * sub + 4 * hh - Q0); \
                const float sl = diag ? 0.f : slope; \
                _Pragma("unroll") for (int i = 0; i < 16; ++i) s[sub][i] = kb0 + sl * (float)((i & 3) + 8 * (i >> 2)); \
                _Pragma("unroll") for (int ks = 0; ks < 4; ++ks) { \
                    const bf16x8 kf = *(const LAS bf16x8*)(kb + ((32 * sub + l31) * ATT_KSTR + comp * 64 + 16 * ks + 8 * hh) * 2); \
                    s[sub] = MFMA32(kf, qfr[ks], s[sub]); } } \
            if (diag) { \
                const float qrel2 = 2.0f * (float)(q0 - Q0 + l31); \
                _Pragma("unroll") for (int sub = 0; sub < 2; ++sub) _Pragma("unroll") for (int i = 0; i < 16; ++i) { const float kr = (float)(32 * sub + 4 * hh + (i & 3) + 8 * (i >> 2)); s[sub][i] += slope * fminf(kr, qrel2 - kr); } } \
            float mt = s[0][0]; \
            _Pragma("unroll") for (int sub = 0; sub < 2; ++sub) _Pragma("unroll") for (int i = 0; i < 16; ++i) mt = fmaxf(mt, s[sub][i]); \
            mt = xor32_max(mt); \
            const bool grow = !__all(mt <= m);                             \
            const float mn = fmaxf(m, mt); \
            const float alpha = __builtin_amdgcn_exp2f((m - mn) * LOG2E); \
            m = mn; \
            const float mL = mn * LOG2E; \
            float ps = 0.f; \
            _Pragma("unroll") for (int sub = 0; sub < 2; ++sub) _Pragma("unroll") for (int i = 0; i < 16; ++i) { const float pv = __builtin_amdgcn_exp2f(fmaf(s[sub][i], LOG2E, -mL)); s[sub][i] = pv; ps += pv; } \
            if (grow) { l = l * alpha; _Pragma("unroll") for (int et = 0; et < 4; ++et) O[et] = O[et] * alpha; } \
            l += ps; \
            _Pragma("unroll") for (int sub = 0; sub < 2; ++sub) _Pragma("unroll") for (int s8 = 0; s8 < 2; ++s8) \
                pf[sub][s8] = pack8(s[sub][8 * s8], s[sub][8 * s8 + 1], s[sub][8 * s8 + 2], s[sub][8 * s8 + 3], s[sub][8 * s8 + 4], s[sub][8 * s8 + 5], s[sub][8 * s8 + 6], s[sub][8 * s8 + 7]); \
            if (comp == 0) ATT_PV(ATT_VSLOT(vs)); else pend = true; \
            __builtin_amdgcn_sched_barrier(0); \
        } \
        {     \
            const bool ok = (kt <= qc) && (qk_ub + slope * (float)(kt * 64 - 1 - Q0) < m - 28.0f); \
            const int v = __all(ok) ? 1 : 0; \
            if (lane == 0) votes[(it & 1) * 8 + wid] = v; \
        } \
        if (kt >= 1) { \
            LAS unsigned char* kb = kbuf + (cur ^ 1) * ATT_KBYTES; LAS unsigned char* vb = ATT_VSLOT(vnext); \
            *(LAS u32x4*)(kb + klds) = PK0; *(LAS u32x4*)(kb + klds + 128) = PK1; \
            *(LAS u32x4*)(vb + vlds) = PK2; *(LAS u32x4*)(vb + vlds + 128) = PK3; \
        } \
        if (pubt >= 0) { asm volatile("" ::: "memory"); if (lane == 0) (void)__hip_atomic_fetch_add(p.ctl + CTL_YREADY(pubt), 1u, __ATOMIC_RELAXED, __HIP_MEMORY_SCOPE_AGENT); pubt = -1; }     \
        __syncthreads(); \
        const LAS int* vv = votes + (it & 1) * 8;                      \
        stop = (vv[0] & vv[1] & vv[2] & vv[3] & vv[4] & vv[5] & vv[6] & vv[7]) != 0 || kt == 0; \
        if (force_lim > 0 && it + 1 >= force_lim) stop = true;         \
        --kt; ++it; vs = vnext; }
    for (;;) {
        bool stop;
        ATT_STEP(sa0, sa1, sa2, sa3, sb0, sb1, sb2, sb3)
        if (stop) break;
        ATT_STEP(sb0, sb1, sb2, sb3, sa0, sa1, sa2, sa3)
        if (stop) break;
    }
    if (comp == 1 && pend) { const int vprev = vs == 0 ? 2 : vs - 1; ATT_PV(ATT_VSLOT(vprev)); }
    __syncthreads();
#undef ATT_STEP
#undef ATT_PV
#undef ATT_VRD
#undef ATT_VMM
#undef ATT_VSLOT
    l = xor32_sum(l);
    const float sc = (comp == 1 ? lam : 1.0f) / l;
    LAS float* X = (LAS float*)lds;
    LAS unsigned char* ot = lds + 2 * ATT_KBYTES + 2 * ATT_VBYTES;
    if (comp == 1) {
#pragma unroll
        for (int et = 0; et < 4; ++et)
#pragma unroll
            for (int i = 0; i < 16; ++i) { const int e = 32 * et + (i & 3) + 8 * (i >> 2) + 4 * hh; X[(rg * 128 + e) * 32 + l31] = O[et][i] * sc; }
    }
    __syncthreads();
    if (comp == 0) {
        float ssq = 0.f;
#pragma unroll
        for (int et = 0; et < 4; ++et)
#pragma unroll
            for (int i = 0; i < 16; ++i) { const int e = 32 * et + (i & 3) + 8 * (i >> 2) + 4 * hh; const float v = O[et][i] * sc - X[(rg * 128 + e) * 32 + l31]; O[et][i] = v; ssq += v * v; }
        ssq = xor32_sum(ssq);
        const float rs = rsqrtf(ssq * (1.0f / 128.0f) + EPS_) * (1.0f - LAMBDA_INIT_F);
        const LAS float* gp = gl + h * 128;
#pragma unroll
        for (int et = 0; et < 4; ++et)
#pragma unroll
            for (int gq = 0; gq < 4; ++gq) { const int e0 = 32 * et + 8 * gq + 4 * hh; const f32x4 g4 = *(const LAS f32x4*)(gp + e0);
                u32x2 w; w.x = cvt_pk_bf16(O[et][4 * gq] * rs * g4[0], O[et][4 * gq + 1] * rs * g4[1]); w.y = cvt_pk_bf16(O[et][4 * gq + 2] * rs * g4[2], O[et][4 * gq + 3] * rs * g4[3]);
                *(LAS u32x2*)(ot + ((rg * 32 + l31) * 136 + e0) * 2) = w; }
    }
    attn_issue(p, has_next ? nb : b, has_next ? nh : h, has_next ? nqb : qb, pre);
    __syncthreads();
    {
        const int row = tid >> 2, seg = tid & 3;
        bf16_t* dst = p.Yb + (tokbase + qb * 128 + row) * 1024 + h * 128 + seg * 32;
#pragma unroll
        for (int j = 0; j < 4; ++j) { const u32x4 w = *(const LAS u32x4*)(ot + (row * 136 + seg * 32 + 8 * j) * 2); st_wt16(dst + 8 * j, w); }
    }
    pubt = b * 8 + (qb >> 1);
}
DI void phase_attn(const MegaParams& p, LAS unsigned char* lds, LAS unsigned char* misc, int force_lim = 0) {
    const int tid = opaque_tid(), lane = tid & 63, G = gridDim.x;
    float a = p.in[17][lane] * p.in[18][lane], c = p.in[19][lane] * p.in[20][lane];
    for (int o = 32; o > 0; o >>= 1) { a += __shfl_xor(a, o); c += __shfl_xor(c, o); }
    const float lam = expf(a) - expf(c) + LAMBDA_INIT_F;
    __syncthreads();
    for (int i = tid; i < 1024; i += 512) ((LAS float*)(misc + 4096))[i] = p.in[21][i];
    __syncthreads();
    const int vcu = (G % 8 == 0) ? ((int)blockIdx.x % 8) * (G / 8) + (int)blockIdx.x / 8 : (int)blockIdx.x;
    const int npair = (1024 - vcu + G - 1) / G;
    auto unit_of = [&](int u, int& b, int& h, int& qb) { const int P = vcu + (u >> 1) * G; const int v = P & 255, i = P >> 8, j = v & 7, sel = (v >> 3) & 1;
        b = v >> 4; h = sel ? (i == 0 ? 1 : (i == 1 ? 6 : (i == 2 ? 2 : 5))) : (i == 0 ? 0 : (i == 1 ? 7 : (i == 2 ? 3 : 4))); qb = (u & 1) ? j : 15 - j; };
    AttnPre pre; int pubt = -1;
    if (npair > 0) { int b, h, qb; unit_of(0, b, h, qb); attn_issue(p, b, h, qb, pre); }
    for (int u = 0; u < 2 * npair; ++u) {
        int b, h, qb, nb = 0, nh = 0, nqb = 0; unit_of(u, b, h, qb);
        const bool has_next = (u + 1 < 2 * npair);
        if (has_next) unit_of(u + 1, nb, nh, nqb);
        attn_unit(p, lds, misc, b, h, qb, lam, force_lim, pre, has_next, nb, nh, nqb, pubt);
    }
    if (pubt >= 0) { asm volatile("s_waitcnt vmcnt(0)" ::: "memory"); if (lane == 0) (void)__hip_atomic_fetch_add(p.ctl + CTL_YREADY(pubt), 1u, __ATOMIC_RELAXED, __HIP_MEMORY_SCOPE_AGENT); }
}
#define MFMA16(a, b, c) __builtin_amdgcn_mfma_f32_16x16x32_bf16((a), (b), (c), 0, 0, 0)
DI float wave_scan_add(float v, int lane) {
#pragma unroll
    for (int o = 1; o < 64; o <<= 1) { const float t = __shfl_up(v, o); if (lane >= o) v += t; }
    return v;
}
DI float wave_scan_max(float v, int lane) {
#pragma unroll
    for (int o = 1; o < 64; o <<= 1) { const float t = __shfl_up(v, o); if (lane >= o) v = fmaxf(v, t); }
    return v;
}
DI float fast_rcp(float x) { return __builtin_amdgcn_rcpf(x); }
DI float fast_sigmoid(float x) { return fast_rcp(1.0f + __expf(-x)); }
DI float one_minus_exp(float t) {
    const float ser = -t * (1.0f + t * (0.5f + t * (0.16666667f + t * 0.041666668f)));
    return t > -0.125f ? ser : 1.0f - __expf(t);
}

#define LRU_XSTR 68
DI void lru_unit(const MegaParams& p, LAS unsigned char* lds, int b, int blk) {
    const int tid = opaque_tid(), wid = __builtin_amdgcn_readfirstlane(tid >> 6), lane = tid & 63, l31 = lane & 31, hh = lane >> 5;
    LAS float* xcf = (LAS float*)lds;
    LAS float* abuf = (LAS float*)(lds + 34816);
    LAS unsigned char* wrt = lds + 34816 + 32768;
    LAS unsigned char* wit = wrt + 9216;
    LAS float* agg = (LAS float*)(wit + 9216);
    LAS float* carry = agg + 1024;
    LAS float* cw = carry + 64;
    LAS float* cb = cw + 256; LAS float* brl = cb + 64; LAS float* bil = brl + 64; LAS float* cl = bil + 64;
    LAS float* ubuf = (LAS float*)(lds + 98304);
    const int c0 = blk * 64;
    __syncthreads();
    for (int i = tid; i < 4096; i += 512) { const int d = i >> 6, e = i & 63;
        const float wr = p.in[7][(size_t)blk * 4096 + i], wi = p.in[9][(size_t)blk * 4096 + i];
        *(LAS bf16_t*)(wrt + (e * 72 + d) * 2) = (bf16_t)(cvt_pk_bf16(wr, 0.f) & 0xffffu);
        *(LAS bf16_t*)(wit + (e * 72 + d) * 2) = (bf16_t)(cvt_pk_bf16(wi, 0.f) & 0xffffu); }
    if (tid < 256) cw[tid] = p.in[5][(tid >> 6) * 512 + c0 + (tid & 63)];
    if (tid < 64) { cb[tid] = p.in[6][c0 + tid]; brl[tid] = p.in[8][c0 + tid]; bil[tid] = p.in[10][c0 + tid];
        const float lm = p.in[11][c0 + tid]; const float ls = lm >= 0.f ? -log1pf(expf(-lm)) : lm - log1pf(expf(lm)); cl[tid] = 8.0f * ls; carry[tid] = 0.f; }
    __syncthreads();
    const bf16_t* P1 = p.P1;
    const size_t tb = (size_t)b * S_;
    u32x4 cv[4][2];
    { const int tok = tid >> 2, cq = (tid & 3) * 16;
#pragma unroll
      for (int tap = 0; tap < 4; ++tap) { const int s = tok + tap - 3; cv[tap][0] = (u32x4){0u, 0u, 0u, 0u}; cv[tap][1] = (u32x4){0u, 0u, 0u, 0u};
          if (s >= 0) { cv[tap][0] = *(const u32x4*)(P1 + (tb + s) * 3072 + c0 + cq); cv[tap][1] = *(const u32x4*)(P1 + (tb + s) * 3072 + c0 + cq + 8); } } }
    for (int tile = 0; tile < 16; ++tile) {
        const int s0 = tile * 128;
        {
            const int tok = tid >> 2, cq = (tid & 3) * 16;
            float acc[16];
#pragma unroll
            for (int j = 0; j < 16; ++j) acc[j] = cb[cq + j];
#pragma unroll
            for (int tap = 0; tap < 4; ++tap) {
                const u32x4 v0 = cv[tap][0], v1 = cv[tap][1];
                const unsigned w[8] = {v0.x, v0.y, v0.z, v0.w, v1.x, v1.y, v1.z, v1.w};
#pragma unroll
                for (int j = 0; j < 8; ++j) { acc[2 * j] += cw[tap * 64 + cq + 2 * j] * bf_lo(w[j]); acc[2 * j + 1] += cw[tap * 64 + cq + 2 * j + 1] * bf_hi(w[j]); }
            }
            if (tile + 1 < 16) {
#pragma unroll
                for (int tap = 0; tap < 4; ++tap) { const size_t s = (size_t)(s0 + 128 + tok + tap - 3); cv[tap][0] = *(const u32x4*)(P1 + (tb + s) * 3072 + c0 + cq); cv[tap][1] = *(const u32x4*)(P1 + (tb + s) * 3072 + c0 + cq + 8); }
            }
#pragma unroll
            for (int j = 0; j < 4; ++j) *(LAS f32x4*)(xcf + tok * LRU_XSTR + cq + 4 * j) = (f32x4){acc[4 * j], acc[4 * j + 1], acc[4 * j + 2], acc[4 * j + 3]};
        }
        __syncthreads();
        {
            const int tg = wid >> 1, nt = wid & 1;
            f32x16 ar, ai;
#pragma unroll
            for (int i = 0; i < 16; ++i) { ar[i] = 0.f; ai[i] = 0.f; }
#pragma unroll
            for (int ks = 0; ks < 4; ++ks) {
                const LAS float* xr = xcf + (tg * 32 + l31) * LRU_XSTR + 16 * ks + 8 * hh;
                const f32x4 x0 = *(const LAS f32x4*)xr, x1 = *(const LAS f32x4*)(xr + 4);
                const bf16x8 af = pack8(x0[0], x0[1], x0[2], x0[3], x1[0], x1[1], x1[2], x1[3]);
                const bf16x8 bfr = *(const LAS bf16x8*)(wrt + ((nt * 32 + l31) * 72 + 16 * ks + 8 * hh) * 2);
                const bf16x8 bfi = *(const LAS bf16x8*)(wit + ((nt * 32 + l31) * 72 + 16 * ks + 8 * hh) * 2);
                ar = MFMA32(af, bfr, ar); ai = MFMA32(af, bfi, ai);
            }
            const int e = nt * 32 + l31;
            const float be_r = brl[e], be_i = bil[e], cle = cl[e];
#pragma unroll
            for (int i = 0; i < 16; ++i) {
                const int tok = tg * 32 + (i & 3) + 8 * (i >> 2) + 4 * hh;
                const float r = fast_sigmoid(ar[i] + be_r), ig = fast_sigmoid(ai[i] + be_i);
                const float log_a = cle * r;
                const float a = __expf(log_a);
                const float xv = xcf[tok * LRU_XSTR + e];
                const float t2 = 2.0f * log_a;
                const float om = t2 > -0.125f ? -t2 * (1.0f + t2 * (0.5f + t2 * (0.16666667f + t2 * 0.041666668f))) : 1.0f - a * a;
                const float u = __builtin_amdgcn_sqrtf(om) * (ig * xv);
                abuf[tok * 64 + e] = a; ubuf[tok * 64 + e] = u;
            }
        }
        __syncthreads();
        {
            const int ch = lane, seg = wid;
            float A = 1.f, B = 0.f;
#pragma unroll
            for (int j = 0; j < 16; ++j) { const int tok = seg * 16 + j; const float a = abuf[tok * 64 + ch], u = ubuf[tok * 64 + ch]; A *= a; B = a * B + u; }
            agg[(seg * 64 + ch) * 2] = A; agg[(seg * 64 + ch) * 2 + 1] = B;
            float gav[16];
#pragma unroll
            for (int j = 0; j < 16; ++j) gav[j] = bf2f(P1[(tb + s0 + seg * 16 + j) * 3072 + 512 + c0 + ch]);
            __syncthreads();
            float h = carry[ch];
            for (int sg = 0; sg < seg; ++sg) h = agg[(sg * 64 + ch) * 2] * h + agg[(sg * 64 + ch) * 2 + 1];
            __syncthreads();
#pragma unroll
            for (int j = 0; j < 16; ++j) {
                const int tok = seg * 16 + j; const float a = abuf[tok * 64 + ch], u = ubuf[tok * 64 + ch];
                h = a * h + u;
                const float g = gav[j]; const float z = 0.7978845608028654f * (g + 0.044715f * g * g * g);
                const float y = h * g * fast_rcp(1.0f + __expf(-2.0f * z));
                p.Yb[(tb + s0 + tok) * 1024 + c0 + ch] = (bf16_t)(cvt_pk_bf16(y, 0.f) & 0xffffu);
            }
            if (seg == 7) carry[ch] = h;
        }
        __syncthreads();
    }
}

typedef short v4i16_t __attribute__((ext_vector_type(4)));
DI bf16x8 tr_frag(LAS unsigned char* tile, int r0, int c0, int fr) {
    LAS unsigned char* a = tile + ((r0 + (fr >> 2)) * 136 + c0 + 4 * (fr & 3)) * 2;
    const v4i16_t lo = __builtin_amdgcn_ds_read_tr16_b64_v4i16((LAS v4i16_t*)a), hi = __builtin_amdgcn_ds_read_tr16_b64_v4i16((LAS v4i16_t*)(a + 4 * 136 * 2));
    return __builtin_shufflevector(lo, hi, 0, 1, 2, 3, 4, 5, 6, 7);
}
#define ML_QSTR 136
#define ML_TSTR 72
DI void mlstm_unit(const MegaParams& p, LAS unsigned char* lds, int b, int hd, const int prb = 0) {
    const int tid = opaque_tid(), wid = __builtin_amdgcn_readfirstlane(tid >> 6), lane = tid & 63, fr = lane & 15, g = lane >> 4;
    LAS unsigned char* Qs = lds;
    LAS unsigned char* Ks = lds + 17408;
    LAS unsigned char* Vs = lds + 34816;
    LAS unsigned char* Ss = lds + 52224;
    LAS float* rsp = (LAS float*)(lds + 61440);
    LAS float* qnp = (LAS float*)(lds + 62464);
    LAS float* ssp = (LAS float*)(lds + 64512);
    LAS float* nvec = (LAS float*)(lds + 66560);
    const bf16_t* P1 = p.P1;
    const size_t tb = (size_t)b * S_;
    const float mbi = p.in[12][hd], mbf = p.in[13][hd];
    const int qrow = tid >> 3, qseg = tid & 7;
    const bf16_t* qg = P1 + (tb + qrow) * 3072 + 1024 + hd * 128 + qseg * 8;
    const bf16_t* kg = P1 + (tb + qrow) * 3072 + 1536 + hd * 128 + qseg * 8;
    const bf16_t* vgp = P1 + (tb + qrow) * 3072 + 2048 + hd * 128 + qseg * 8;
    const int qlds = (qrow * ML_QSTR + qseg * 8) * 2;
    LAS float* Tu = (LAS float*)(lds + 67072);
    LAS float* TM = Tu + 2048;
    LAS float* Twi = TM + 2048;
    LAS float* Tfl = Twi + 2048;
    LAS float* Tws = Tfl + 2048;
    LAS float* Tsc = Tws + 2048;
    __syncthreads();
    if (tid < 128) nvec[tid] = 0.f;
#pragma unroll
    for (int q = 0; q < 4; ++q) {
        const int c = 4 * wid + q;
        const float ipre = p.ipfp[(tb + c * 64 + lane) * 8 + hd] + mbi, fpre = p.ipfp[(tb + c * 64 + lane) * 8 + 4 + hd] + mbf;
        const float e = __expf(-fabsf(fpre));
        const float lf = fminf(fpre, 0.f) - __logf(1.0f + e);
        const float bl = wave_scan_add(lf, lane);
        const float ul = ipre - bl;
        const float pm = wave_scan_max(ul, lane);
        Tu[c * 64 + lane] = ul; TM[c * 64 + lane] = pm; Tfl[c * 64 + lane] = bl;
    }
    __syncthreads();
    if (tid == 0) { float mc = 0.f; for (int c = 0; c < 32; ++c) { Tsc[c] = mc; const float M63 = fmaxf(mc, TM[c * 64 + 63]); Tsc[32 + c] = __expf(mc - M63); mc = Tfl[c * 64 + 63] + M63; } }
    __syncthreads();
#pragma unroll
    for (int q = 0; q < 4; ++q) {
        const int c = 4 * wid + q;
        const float mc = Tsc[c];
        const float Ml = fmaxf(mc, TM[c * 64 + lane]), M63 = fmaxf(mc, TM[c * 64 + 63]);
        __builtin_amdgcn_s_waitcnt(0xC07F);
        const float bl = Tfl[c * 64 + lane], ul = Tu[c * 64 + lane];
        const float wi = __expf(mc - Ml), fl = __expf(-bl - Ml), ws = __expf(ul - M63);
        TM[c * 64 + lane] = Ml; Twi[c * 64 + lane] = wi; Tfl[c * 64 + lane] = fl; Tws[c * 64 + lane] = ws;
    }
    f32x4 Cst[8];
#pragma unroll
    for (int dt = 0; dt < 8; ++dt) Cst[dt] = (f32x4){0.f, 0.f, 0.f, 0.f};
    u32x4 rq0, rq1, rk0, rk1, rv0, rv1;
    rq0 = *(const u32x4*)qg; rq1 = *(const u32x4*)(qg + 64); rk0 = *(const u32x4*)kg; rk1 = *(const u32x4*)(kg + 64); rv0 = *(const u32x4*)vgp; rv1 = *(const u32x4*)(vgp + 64);
    const float gn0 = p.in[14][hd * 128 + 16 * wid + 4 * g], gn1 = p.in[14][hd * 128 + 16 * wid + 4 * g + 1], gn2 = p.in[14][hd * 128 + 16 * wid + 4 * g + 2], gn3 = p.in[14][hd * 128 + 16 * wid + 4 * g + 3];
    __syncthreads();
    for (int c = 0; c < 32; ++c) {
        const size_t t0 = tb + (size_t)c * 64;
        *(LAS u32x4*)(Qs + qlds) = rq0; *(LAS u32x4*)(Qs + qlds + 128) = rq1; *(LAS u32x4*)(Ks + qlds) = rk0; *(LAS u32x4*)(Ks + qlds + 128) = rk1;
        *(LAS u32x4*)(Vs + qlds) = rv0; *(LAS u32x4*)(Vs + qlds + 128) = rv1;
        u32x2 og[4];
#pragma unroll
        for (int lt = 0; lt < 4; ++lt) og[lt] = *(const u32x2*)(P1 + (t0 + 16 * lt + fr) * 3072 + 2560 + hd * 128 + 16 * wid + 4 * g);
        if (c + 1 < 32) {
            const size_t adv = (size_t)(c + 1) * 64;
            rq0 = *(const u32x4*)(qg + adv * 3072); rq1 = *(const u32x4*)(qg + adv * 3072 + 64); rk0 = *(const u32x4*)(kg + adv * 3072); rk1 = *(const u32x4*)(kg + adv * 3072 + 64);
            rv0 = *(const u32x4*)(vgp + adv * 3072); rv1 = *(const u32x4*)(vgp + adv * 3072 + 64);
        }
        const LAS float* tu = Tu + c * 64; const LAS float* tM = TM + c * 64; const LAS float* twi = Twi + c * 64; const LAS float* tws = Tws + c * 64;
        const float decay = Tsc[32 + c];
        __syncthreads();
        if (!(prb & 4)) {
            const int lt = wid >> 1;
            const float Mcol = tM[16 * lt + fr];
#pragma unroll
            for (int q = 0; q < 2; ++q) {
                const int st = 2 * (wid & 1) + q;
                f32x4 acc = (f32x4){0.f, 0.f, 0.f, 0.f};
                float rs = 0.f;
                u32x2 w2 = (u32x2){0u, 0u};
                if (st <= lt) {
                    bf16x8 af[4], bq[4];
#pragma unroll
                    for (int kk = 0; kk < 4; ++kk) { af[kk] = *(const LAS bf16x8*)(Ks + ((16 * st + fr) * ML_QSTR + 32 * kk + 8 * g) * 2); bq[kk] = *(const LAS bf16x8*)(Qs + ((16 * lt + fr) * ML_QSTR + 32 * kk + 8 * g) * 2); }
                    __builtin_amdgcn_sched_barrier(0);
#pragma unroll
                    for (int kk = 0; kk < 4; ++kk) acc = MFMA16(af[kk], bq[kk], acc);
                    float v[4];
                    const f32x4 us4 = *(const LAS f32x4*)(tu + 16 * st + 4 * g);
#pragma unroll
                    for (int r = 0; r < 4; ++r) { const int s = 16 * st + 4 * g + r, l = 16 * lt + fr;
                        v[r] = (s <= l) ? acc[r] * __expf(us4[r] - Mcol) : 0.f; rs += v[r]; }
                    w2.x = cvt_pk_bf16(v[0], v[1]); w2.y = cvt_pk_bf16(v[2], v[3]);
                }
                *(LAS u32x2*)(Ss + ((16 * lt + fr) * ML_TSTR + 16 * st + 4 * g) * 2) = w2;
                rs = xor16_sum(rs); rs = xor32_sum(rs);
                if (g == 0) rsp[st * 64 + 16 * lt + fr] = rs;
            }
        }
        {
            const LAS unsigned char* qr = Qs + (lane * ML_QSTR + 16 * wid) * 2;
            const u32x4 q0 = *(const LAS u32x4*)qr, q1 = *(const LAS u32x4*)(qr + 16);
            const unsigned w[8] = {q0.x, q0.y, q0.z, q0.w, q1.x, q1.y, q1.z, q1.w};
            float a = 0.f;
#pragma unroll
            for (int j = 0; j < 8; ++j) a += bf_lo(w[j]) * nvec[16 * wid + 2 * j] + bf_hi(w[j]) * nvec[16 * wid + 2 * j + 1];
            qnp[wid * 64 + lane] = a;
        }
        __syncthreads();
        f32x4 H[4];
        {
            bf16x8 cf[4];
#pragma unroll
            for (int kk = 0; kk < 4; ++kk) cf[kk] = pack8(Cst[2 * kk][0], Cst[2 * kk][1], Cst[2 * kk][2], Cst[2 * kk][3], Cst[2 * kk + 1][0], Cst[2 * kk + 1][1], Cst[2 * kk + 1][2], Cst[2 * kk + 1][3]);
            bf16x8 vfr[2];
#pragma unroll
            for (int kk = 0; kk < 2; ++kk) vfr[kk] = tr_frag(Vs, 32 * kk + 8 * g, 16 * wid, fr);
            float qn = 0.f, rsum = 0.f;
#pragma unroll
            for (int q = 0; q < 8; ++q) qn += qnp[q * 64 + lane];
#pragma unroll
            for (int q = 0; q < 4; ++q) rsum += rsp[q * 64 + lane];
            const float den = twi[lane] * qn + rsum;
            const float hdiv = fast_rcp(fmaxf(fabsf(den), Tfl[c * 64 + lane]));
            float hdv[4];
#pragma unroll
            for (int lt = 0; lt < 4; ++lt) hdv[lt] = __shfl(hdiv, 16 * lt + fr);
#pragma unroll
            for (int lt = 0; lt < 4; ++lt) {
                f32x4 acc = (f32x4){0.f, 0.f, 0.f, 0.f};
#pragma unroll
                for (int kk = 0; kk < 4; ++kk) {
                    const LAS unsigned char* qp = Qs + ((16 * lt + fr) * ML_QSTR + 32 * kk + 4 * g) * 2;
                    const s16x4 lo = *(const LAS s16x4*)qp, hi = *(const LAS s16x4*)(qp + 32);
                    const bf16x8 bq = __builtin_shufflevector(lo, hi, 0, 1, 2, 3, 4, 5, 6, 7);
                    acc = MFMA16(cf[kk], bq, acc);
                }
                const float wl = twi[16 * lt + fr];
                acc = acc * wl;
#pragma unroll
                for (int kk = 0; kk < 2; ++kk) {
                    const bf16x8 bs = *(const LAS bf16x8*)(Ss + ((16 * lt + fr) * ML_TSTR + 32 * kk + 8 * g) * 2);
                    acc = MFMA16(vfr[kk], bs, acc);
                }
                const float hd_ = hdv[lt];
                acc = acc * hd_;
                H[lt] = acc;
                float sq = acc[0] * acc[0] + acc[1] * acc[1] + acc[2] * acc[2] + acc[3] * acc[3];
                sq = xor16_sum(sq); sq = xor32_sum(sq);
                if (g == 0) ssp[wid * 64 + 16 * lt + fr] = sq;
            }
            bf16x8 vw[2];
#pragma unroll
            for (int kk = 0; kk < 2; ++kk) {
                const f32x4 w0 = *(const LAS f32x4*)(tws + 32 * kk + 8 * g), w1 = *(const LAS f32x4*)(tws + 32 * kk + 8 * g + 4);
                const u32x4 vv = __builtin_bit_cast(u32x4, vfr[kk]);
                vw[kk] = pack8(bf_lo(vv.x) * w0[0], bf_hi(vv.x) * w0[1], bf_lo(vv.y) * w0[2], bf_hi(vv.y) * w0[3], bf_lo(vv.z) * w1[0], bf_hi(vv.z) * w1[1], bf_lo(vv.w) * w1[2], bf_hi(vv.w) * w1[3]);
            }
            const f32x4 wa0 = *(const LAS f32x4*)(tws + 8 * g), wa1 = *(const LAS f32x4*)(tws + 8 * g + 4), wb0 = *(const LAS f32x4*)(tws + 32 + 8 * g), wb1 = *(const LAS f32x4*)(tws + 32 + 8 * g + 4);
            float npart = 0.f;
            if (!(prb & 2)) {
                bf16x8 aka[2], akb[2];
#define ML_KRD(F, dt) do { F[0] = tr_frag(Ks, 8 * g, 16 * (dt), fr); F[1] = tr_frag(Ks, 32 + 8 * g, 16 * (dt), fr); } while (0)
#define ML_KMM(F, dt) do { f32x4 acc = Cst[dt] * decay; acc = MFMA16(F[0], vw[0], acc); acc = MFMA16(F[1], vw[1], acc); Cst[dt] = acc; \
                    if ((dt) == wid) { const u32x4 x0 = __builtin_bit_cast(u32x4, F[0]), x1 = __builtin_bit_cast(u32x4, F[1]);     \
                        npart = bf_lo(x0.x) * wa0[0] + bf_hi(x0.x) * wa0[1] + bf_lo(x0.y) * wa0[2] + bf_hi(x0.y) * wa0[3] + bf_lo(x0.z) * wa1[0] + bf_hi(x0.z) * wa1[1] + bf_lo(x0.w) * wa1[2] + bf_hi(x0.w) * wa1[3] \
                              + bf_lo(x1.x) * wb0[0] + bf_hi(x1.x) * wb0[1] + bf_lo(x1.y) * wb0[2] + bf_hi(x1.y) * wb0[3] + bf_lo(x1.z) * wb1[0] + bf_hi(x1.z) * wb1[1] + bf_lo(x1.w) * wb1[2] + bf_hi(x1.w) * wb1[3]; } } while (0)
                ML_KRD(aka, 0); ML_KRD(akb, 1); __builtin_amdgcn_sched_barrier(0);
                ML_KMM(aka, 0); __builtin_amdgcn_sched_barrier(0); ML_KRD(aka, 2); __builtin_amdgcn_sched_barrier(0);
                ML_KMM(akb, 1); __builtin_amdgcn_sched_barrier(0); ML_KRD(akb, 3); __builtin_amdgcn_sched_barrier(0);
                ML_KMM(aka, 2); __builtin_amdgcn_sched_barrier(0); ML_KRD(aka, 4); __builtin_amdgcn_sched_barrier(0);
                ML_KMM(akb, 3); __builtin_amdgcn_sched_barrier(0); ML_KRD(akb, 5); __builtin_amdgcn_sched_barrier(0);
                ML_KMM(aka, 4); __builtin_amdgcn_sched_barrier(0); ML_KRD(aka, 6); __builtin_amdgcn_sched_barrier(0);
                ML_KMM(akb, 5); __builtin_amdgcn_sched_barrier(0); ML_KRD(akb, 7); __builtin_amdgcn_sched_barrier(0);
                ML_KMM(aka, 6); __builtin_amdgcn_sched_barrier(0); ML_KMM(akb, 7);
#undef ML_KRD
#undef ML_KMM
            }
            npart = xor16_sum(npart); npart = xor32_sum(npart);
            if (g == 0) nvec[16 * wid + fr] = decay * nvec[16 * wid + fr] + npart;
        }
        __syncthreads();
        if (prb & 1) { asm volatile("" :: "v"(H[0]), "v"(H[1]), "v"(H[2]), "v"(H[3]), "v"(og[0]), "v"(og[1]), "v"(og[2]), "v"(og[3])); }
        else {
            float ssq = 0.f;
#pragma unroll
            for (int q = 0; q < 8; ++q) ssq += ssp[q * 64 + lane];
            const float rstd = rsqrtf(ssq * (1.0f / 128.0f) + EPS_);
            float rlv[4];
#pragma unroll
            for (int lt = 0; lt < 4; ++lt) rlv[lt] = __shfl(rstd, 16 * lt + fr);
#pragma unroll
            for (int lt = 0; lt < 4; ++lt) {
                const float rl = rlv[lt];
                const float o0 = bf_lo(og[lt].x), o1 = bf_hi(og[lt].x), o2 = bf_lo(og[lt].y), o3 = bf_hi(og[lt].y);
                u32x2 w; w.x = cvt_pk_bf16(H[lt][0] * rl * gn0 * fast_sigmoid(o0), H[lt][1] * rl * gn1 * fast_sigmoid(o1)); w.y = cvt_pk_bf16(H[lt][2] * rl * gn2 * fast_sigmoid(o2), H[lt][3] * rl * gn3 * fast_sigmoid(o3));
                *(u32x2*)(p.Yb + (t0 + 16 * lt + fr) * 1024 + 512 + hd * 128 + 16 * wid + 4 * g) = w;
            }
        }
    }
}

struct ConvDesc { const float* src; const float* gain; bf16_t* dst; int ldsrc, colA, colB, k0, K, row0; float scale; };
#define CONV_TILES (AUX_PREP_GROUPS + MOE_PREP_GROUPS)
DI ConvDesc conv_desc(const MegaParams& p, int g) {
    ConvDesc d; d.gain = nullptr; d.scale = 1.0f; d.ldsrc = 1024; d.K = 1024;
    if (g < 64) { const int rt = g >> 2; d.src = p.in[4]; d.colA = rt * 64; d.colB = d.colA + 32; d.k0 = (g & 3) * 256; d.dst = p.Wout; d.row0 = rt * 64; }
    else if (g < 256) { const int u = g - 64, r0 = (u >> 2) * 64; d.src = p.in[15]; d.ldsrc = 3072; d.colA = r0; d.colB = r0 + 32; d.k0 = (u & 3) * 256; d.gain = p.in[1] + D_; d.scale = r0 < 1024 ? 0.125f : 1.0f; d.dst = p.Wqkv; d.row0 = r0; }
    else if (g < 320) { const int u = g - 256, rt = u >> 2; d.src = p.in[16]; d.colA = rt * 64; d.colB = d.colA + 32; d.k0 = (u & 3) * 256; d.dst = p.Wo; d.row0 = rt * 64; }
    else { const int h = g - 320;
        if (h < 4096) { const int mat = h >> 6, rt = (h >> 2) & 15, r0 = rt * 64, pn = r0 >> 8, wc = (r0 & 255) >> 6;
            d.src = p.in[26] + (size_t)mat * 1024 * 1024; d.colA = 128 * pn + 32 * wc; d.colB = 512 + d.colA; d.k0 = (h & 3) * 256; d.gain = p.in[2] + (mat >> 5) * D_; d.dst = p.Wup + (size_t)mat * 1024 * 1024; d.row0 = r0; }
        else { const int hh = h - 4096, mat = hh >> 5, rt = (hh >> 1) & 15; d.src = p.in[27] + (size_t)mat * 512 * 1024; d.colA = rt * 64; d.colB = d.colA + 32; d.k0 = (hh & 1) * 256; d.dst = p.Wdn + (size_t)mat * 1024 * 512; d.K = 512; d.row0 = rt * 64; } }
    return d;
}
DI void conv_load(const ConvDesc& d, float4 (&v)[8], float (&gv)[8]) {
    const int tid = opaque_tid(), kk = tid >> 4, c4 = (tid & 15) * 4, col = c4 < 32 ? d.colA + c4 : d.colB + c4 - 32;
#pragma unroll
    for (int q = 0; q < 8; ++q) v[q] = ld_nt4(d.src + (size_t)(d.k0 + kk + 32 * q) * d.ldsrc + col);
    if (d.gain) {
#pragma unroll
        for (int q = 0; q < 8; ++q) gv[q] = d.gain[d.k0 + kk + 32 * q];
    } else {
#pragma unroll
        for (int q = 0; q < 8; ++q) gv[q] = 1.0f;
    }
}
DI void conv_finish(const ConvDesc& d, const float4 (&v)[8], const float (&gv)[8], LAS float* tl) {
    const int tid = opaque_tid();
    { const int kk = tid >> 4, c4 = (tid & 15) * 4;
#pragma unroll
      for (int q = 0; q < 8; ++q) { const int k = kk + 32 * q; const float g = gv[q] * d.scale;
          tl[k * 65 + c4 + 0] = v[q].x * g; tl[k * 65 + c4 + 1] = v[q].y * g; tl[k * 65 + c4 + 2] = v[q].z * g; tl[k * 65 + c4 + 3] = v[q].w * g; } }
    __syncthreads();
    { const int n = tid >> 3, k8 = tid & 7;
#pragma unroll
      for (int q = 0; q < 4; ++q) { const int ks = (k8 + 8 * q) * 8;
          float w8[8];
#pragma unroll
          for (int j = 0; j < 8; ++j) w8[j] = tl[(ks + j) * 65 + n];
          u32x4 w; w.x = cvt_pk_bf16(w8[0], w8[1]); w.y = cvt_pk_bf16(w8[2], w8[3]); w.z = cvt_pk_bf16(w8[4], w8[5]); w.w = cvt_pk_bf16(w8[6], w8[7]);
          *(u32x4*)(d.dst + (size_t)(d.row0 + n) * d.K + d.k0 + ks) = w; } }
    __syncthreads();
}
DI void conv_queue(const MegaParams& p, LAS unsigned char* lds, LAS unsigned char* misc) {
    LAS float* tl = (LAS float*)lds;
    LAS int* qs = (LAS int*)(misc + 2048);
    unsigned* q = p.ctl + CTL_QUEUE;
    __syncthreads();
    if (threadIdx.x == 0) qs[0] = (int)atomicAdd(q, 2u);
    __syncthreads();
    int base = __builtin_amdgcn_readfirstlane(qs[0]);
    __syncthreads();
    while (base < CONV_TILES) {
        float4 va[8], vb[8]; float ga[8], gb[8];
        const bool hasb = base + 1 < CONV_TILES;
        const ConvDesc da = conv_desc(p, base), db = conv_desc(p, hasb ? base + 1 : base);
        conv_load(da, va, ga);
        if (hasb) conv_load(db, vb, gb);
        int pend;
        if (threadIdx.x == 0) pend = (int)atomicAdd(q, 2u);
        conv_finish(da, va, ga, tl);
        if (hasb) conv_finish(db, vb, gb, tl);
        if (threadIdx.x == 0) qs[0] = pend;
        __syncthreads();
        base = __builtin_amdgcn_readfirstlane(qs[0]);
        __syncthreads();
    }
}

DI void phase_mixer(const MegaParams& p, LAS unsigned char* lds, LAS unsigned char* misc, int only = 0) {
    for (int u = blockIdx.x; u < 192; u += gridDim.x) {
        if (u < 64) { if ((only & 3) != 2) mlstm_unit(p, lds, u >> 2, u & 3, only >> 4); }
        else { if ((only & 3) != 1) lru_unit(p, lds, (u - 64) >> 3, (u - 64) & 7); }
    }
    if (p.prep_mask & 64u) conv_queue(p, lds, misc);
}
#ifndef HAVE_MIXER
#define HAVE_MIXER 1
#endif
#ifndef HAVE_ATTN
#define HAVE_ATTN 1
#endif
__global__ void __launch_bounds__(512, 2) mega(MegaParams p) {
    extern __shared__ __attribute__((aligned(16))) unsigned char lds_raw[];
    LAS unsigned char* lds = (LAS unsigned char*)lds_raw;
    LAS unsigned char* misc = lds + MISC_OFF;
    const int tid = threadIdx.x, G = gridDim.x;
    const int vcu = (G % 8 == 0) ? ((int)blockIdx.x % 8) * (G / 8) + (int)blockIdx.x / 8 : (int)blockIdx.x;
    (void)vcu;
    if (tid < 4) ((LAS unsigned*)(misc + 1024))[tid] = 0u;
    __syncthreads();
    XcdBarrier bar = xcd_barrier_post(p.ctl, (volatile LAS unsigned*)(misc + 1024));
    const int lo = p.ph_lo, hi = p.ph_hi;
#define IN(k) (lo <= (k) && (k) < hi)
#define SEAM(k) do { if (IN(k) && IN((k) + 1)) xcd_barrier(bar); } while (0)

    if (IN(0)) { asm volatile("; PHASE_MARK 0"); } if (IN(0)) phase_prep(p, lds);
    SEAM(0);
    if (IN(1)) { asm volatile("; PHASE_MARK 1"); } if (IN(1)) {
        { gm::PlainSched S{p.xb, p.WinN, T_ / 256, 3072 / 256, 1024, G, (int)blockIdx.x, opaque_tid() * 16, nullptr, 0u}; gm::EpiPlainBf16 E{p.P1, 3072, nullptr}; gm::gemm_phase(lds, 1024, S, E); }
    }
    SEAM(1);
    if (IN(2)) { asm volatile("; PHASE_MARK 2"); } if (IN(2)) phase_mixer(p, lds, misc);
    SEAM(2);
    if (IN(3)) { asm volatile("; PHASE_MARK 3"); } if (IN(3)) { gm::PlainSched S{p.Yb, p.Wout, T_ / 256, 4, 1024, G, (int)blockIdx.x, opaque_tid() * 16, nullptr, 0u}; gm::EpiResid E{p.xb, p.rstd, p.ctl + CTL_DREADY(0, 0)}; gm::gemm_phase(lds, 1024, S, E); }
    if (IN(4)) { asm volatile("; PHASE_MARK 4"); } if (IN(4)) phase_router(p, lds, p.Wr, p.in[23], p.in[25], p.ctl + CTL_CNT(0), p.ctl + CTL_DREADY(0, 0));
    SEAM(4);
    if (IN(5)) { asm volatile("; PHASE_MARK 5"); } if (IN(5)) { MoeTables tb = moe_tables(misc, p.ctl + CTL_CNT(0));
        { MoeUpSched S{p.xb, p.Wup, p.lists, tb, G, (int)blockIdx.x, opaque_tid() * 16}; EpiSwiglu E{p.act, p.slot_rs, tb.tp, p.ctl + CTL_MREADY(0, 0)}; gm::gemm_phase(lds, 1024, S, E); }
        asm volatile("; PHASE_MARK 6");
        { MoeDownSched S{p.act, p.Wdn, tb, G, (int)blockIdx.x, opaque_tid() * 16, p.ctl + CTL_MREADY(0, 0), p.ctl + XB_TMO}; EpiMoeDown E{p.ybuf, p.lists, p.slot_gw, tb.tp}; gm::gemm_phase(lds, 512, S, E); } }
    SEAM(6);
    if (IN(7)) { asm volatile("; PHASE_MARK 7"); } if (IN(7)) phase_combine<0>(p, nullptr, nullptr);
    SEAM(7);
    if (IN(8)) { asm volatile("; PHASE_MARK 8"); } if (IN(8)) {
        { gm::PlainSched S{p.xb, p.Wqkv, T_ / 256, 3072 / 256, 1024, G, (int)blockIdx.x, opaque_tid() * 16, nullptr, 0u}; gm::EpiQK E{p.P1, p.ctl + CTL_KMAX}; gm::gemm_phase(lds, 1024, S, E); }
    }
    SEAM(8);
    if (IN(9)) { asm volatile("; PHASE_MARK 9"); } if (IN(9)) phase_attn(p, lds, misc);
    if (IN(10)) { asm volatile("; PHASE_MARK 10"); } if (IN(10)) { gm::PlainSchedT<true> S{p.Yb, p.Wo, T_ / 256, 4, 1024, G, (int)blockIdx.x, opaque_tid() * 16, p.ctl + CTL_YREADY(0), 128u}; gm::EpiResid E{p.xb, p.rstd, p.ctl + CTL_DREADY(1, 0)}; gm::gemm_phase(lds, 1024, S, E); }
    if (IN(11)) { asm volatile("; PHASE_MARK 11"); } if (IN(11)) phase_router(p, lds, p.Wr + 48 * 1024, p.in[23] + 4, p.in[25] + 32, p.ctl + CTL_CNT(1), p.ctl + CTL_DREADY(1, 0));
    SEAM(11);
    if (IN(12)) { asm volatile("; PHASE_MARK 12"); } if (IN(12)) { MoeTables tb = moe_tables(misc, p.ctl + CTL_CNT(1));
        { MoeUpSched S{p.xb, p.Wup + (size_t)32 * 1024 * 1024, p.lists, tb, G, (int)blockIdx.x, opaque_tid() * 16}; EpiSwiglu E{p.act, p.slot_rs, tb.tp, p.ctl + CTL_MREADY(1, 0)}; gm::gemm_phase(lds, 1024, S, E); }
        asm volatile("; PHASE_MARK 13");
        { MoeDownSched S{p.act, p.Wdn + (size_t)32 * 1024 * 512, tb, G, (int)blockIdx.x, opaque_tid() * 16, p.ctl + CTL_MREADY(1, 0), p.ctl + XB_TMO}; EpiMoeDown E{p.ybuf, p.lists, p.slot_gw, tb.tp}; gm::gemm_phase(lds, 512, S, E); } }
    SEAM(13);
    if (IN(14)) { asm volatile("; PHASE_MARK 14"); } if (IN(14)) phase_combine<1>(p, p.out, p.in[28]);
#undef IN
#undef SEAM
}
static char* carve_mega(char* ws, MegaParams& p) {
    char* q = ws; auto tk = [&](size_t b) { char* r = q; q += (b + 255) & ~(size_t)255; return r; };
    p.ctl = (unsigned*)tk(98304);
    p.WinN = (bf16_t*)tk((size_t)3072 * 1024 * 2); p.WinT = nullptr; p.Wout = (bf16_t*)tk((size_t)1024 * 1024 * 2);
    p.Wqkv = (bf16_t*)tk((size_t)3072 * 1024 * 2); p.Wo = (bf16_t*)tk((size_t)1024 * 1024 * 2);
    p.Wup = (bf16_t*)tk((size_t)64 * 1024 * 1024 * 2); p.Wdn = (bf16_t*)tk((size_t)64 * 1024 * 512 * 2); p.Wr = (bf16_t*)tk((size_t)2 * 48 * 1024 * 2);
    p.xb = (bf16_t*)tk((size_t)T_ * 1024 * 2); p.rstd = (float*)tk((size_t)T_ * 4); p.ipfp = (float*)tk((size_t)T_ * 8 * 4);
    char* rp = tk((size_t)T_ * 3072 * 2);
    p.P1 = (bf16_t*)rp; p.PT = nullptr;
    p.act = (bf16_t*)rp; p.ybuf = (bf16_t*)(rp + (((size_t)(2 * T_ + 8192) * 512 * 2 + 255) & ~(size_t)255));
    p.Yb = (bf16_t*)tk((size_t)T_ * 1024 * 2);
    p.lists = (int*)tk((size_t)32 * T_ * 4); p.slot_rs = (float*)tk((size_t)32 * T_ * 4); p.slot_gw = (float*)tk((size_t)32 * T_ * 4);
    p.dA = (bf16_t*)tk((size_t)T_ * D_ * 2); p.hB = (bf16_t*)tk((size_t)T_ * D_ * 2);
    return q;
}
static int mega_grid() {
    static int grid = 0;
    if (grid == 0) {
        int dev = 0, cus = 0, per_cu = 0; (void)hipGetDevice(&dev); (void)hipDeviceGetAttribute(&cus, hipDeviceAttributeMultiprocessorCount, dev);
        (void)hipFuncSetAttribute((const void*)mega, hipFuncAttributeMaxDynamicSharedMemorySize, MEGA_LDS_BYTES);
        (void)hipOccupancyMaxActiveBlocksPerMultiprocessor(&per_cu, (const void*)mega, 512, MEGA_LDS_BYTES);
        (void)hipGetLastError();
        grid = cus > 0 ? cus : 256;
    }
    return grid;
}
extern "C" void kernel_launch(void* const* d_in, const int* in_sizes, int n_in, void* d_out, int out_size, void* d_ws, size_t ws_size, hipStream_t stream) {
    MegaParams p{};
    for (int i = 0; i < 29; ++i) p.in[i] = (const float*)d_in[i];
    p.out = (float*)d_out;
    (void)carve_mega((char*)d_ws, p);
    p.prep_mask = 0x1c3u;     p.pad = -1; p.ph_lo = 0; p.ph_hi = 15;
    (void)hipMemsetAsync(p.ctl, 0, 98304, stream);
    hipLaunchKernelGGL(mega, dim3(mega_grid()), dim3(512), MEGA_LDS_BYTES, stream, p);
}
```
